# Optimizing an MI355X kernel written in HIP

```python
import math
import jax, jax.numpy as jnp
from jax import lax
import numpy as np

D_MODEL = 1024
BATCH = 16
SEQ = 2048
DEPTH = 1

MIX_WIDTH = D_MODEL
POOL_WIDTH = MIX_WIDTH // 2
POOL_GROUPS = 4
POOL_GROUP_DIM = POOL_WIDTH // POOL_GROUPS
POOL_WINDOWS = (2, 4, 8, 16)
ATTN_WIDTH = MIX_WIDTH - POOL_WIDTH
HEAD_DIM = 64
N_HEADS = ATTN_WIDTH // HEAD_DIM
D_FF = 2816
Q_BLOCK = 128
IN_COLS = POOL_WIDTH + 3 * ATTN_WIDTH + N_HEADS
EPS = 1e-6

kernel_name = "hymba_pool_fox_macaron_block"


def rmsnorm(x, g):
    xf = x.astype(jnp.float32)
    y = xf * lax.rsqrt(jnp.mean(xf * xf, axis=-1, keepdims=True) + EPS)
    return (y * g.astype(jnp.float32)).astype(x.dtype)


def swiglu(h, w_gate, w_up, w_down):
    return (jax.nn.silu(h @ w_gate) * (h @ w_up)) @ w_down


def causal_window_mean(v, w):
    B, S, C = v.shape
    vf = v.astype(jnp.float32)
    cs = jnp.cumsum(vf, axis=1)
    shifted = jnp.concatenate([jnp.zeros((B, w, C), jnp.float32), cs[:, : S - w]], axis=1)
    count = jnp.minimum(jnp.arange(1, S + 1, dtype=jnp.float32), float(w))
    return ((cs - shifted) / count[None, :, None]).astype(v.dtype)


def pool_mixer(pv, pool_w, pool_scale):
    B, S, _ = pv.shape
    groups = pv.reshape(B, S, POOL_GROUPS, POOL_GROUP_DIM)
    pooled = jnp.stack(
        [causal_window_mean(groups[:, :, g], POOL_WINDOWS[g]) for g in range(POOL_GROUPS)], axis=2
    ) - groups
    mixed = jnp.einsum("bsgc,gcd->bsgd", pooled, pool_w)
    return mixed.reshape(B, S, POOL_WIDTH) * pool_scale


def forgetting_attention(q, k, v, f_logit, b_forget, q_norm, k_norm):
    B, S, H, Dh = q.shape
    q = rmsnorm(q, q_norm).transpose(0, 2, 1, 3)
    k = rmsnorm(k, k_norm).transpose(0, 2, 1, 3)
    v = v.transpose(0, 2, 1, 3)
    log_f = jax.nn.log_sigmoid((f_logit + b_forget).astype(jnp.float32))
    F = jnp.cumsum(log_f, axis=1).transpose(0, 2, 1)
    scale = 1.0 / math.sqrt(Dh)
    outs = []
    for i in range(S // Q_BLOCK):
        q0, end = i * Q_BLOCK, (i + 1) * Q_BLOCK
        qb = q[:, :, q0:end]
        kb, vb = k[:, :, :end], v[:, :, :end]
        logits = jnp.einsum("bhqd,bhkd->bhqk", qb, kb).astype(jnp.float32) * scale
        logits = logits + F[:, :, q0:end, None] - F[:, :, None, :end]
        q_pos = jnp.arange(q0, end)[:, None]
        k_pos = jnp.arange(end)[None, :]
        logits = jnp.where(q_pos >= k_pos, logits, -jnp.inf)
        p = jax.nn.softmax(logits, axis=-1).astype(vb.dtype)
        outs.append(jnp.einsum("bhqk,bhkd->bhqd", p, vb))
    o = jnp.concatenate(outs, axis=2)
    return o.transpose(0, 2, 1, 3).reshape(B, S, H * Dh)


def setup_inputs(seed: int = 0) -> dict:
    key = jax.random.key(seed)
    ks = jax.random.split(key, 24)
    f32 = jnp.float32

    def nrm(k, shape, fan_in):
        return jax.random.normal(k, shape, f32) * fan_in ** -0.5

    def gain(k, shape):
        return 1.0 + 0.02 * jax.random.normal(k, shape, f32)

    return {
        "x": jax.random.normal(ks[0], (BATCH, SEQ, D_MODEL), f32),
        "ffn1_norm": gain(ks[1], (D_MODEL,)),
        "ffn1_w_gate": nrm(ks[2], (D_MODEL, D_FF), D_MODEL),
        "ffn1_w_up": nrm(ks[3], (D_MODEL, D_FF), D_MODEL),
        "ffn1_w_down": nrm(ks[4], (D_FF, D_MODEL), D_FF),
        "mix_norm": gain(ks[5], (D_MODEL,)),
        "w_in": nrm(ks[6], (D_MODEL, IN_COLS), D_MODEL),
        "b_forget": jax.random.uniform(ks[7], (N_HEADS,), f32, 1.0, 4.0),
        "pool_w": nrm(ks[8], (POOL_GROUPS, POOL_GROUP_DIM, POOL_GROUP_DIM), POOL_GROUP_DIM),
        "pool_scale": gain(ks[9], (POOL_WIDTH,)),
        "q_norm": gain(ks[10], (HEAD_DIM,)),
        "k_norm": gain(ks[11], (HEAD_DIM,)),
        "out_norm_pool": gain(ks[12], (POOL_WIDTH,)),
        "out_norm_attn": gain(ks[13], (ATTN_WIDTH,)),
        "w_out": nrm(ks[14], (MIX_WIDTH, D_MODEL), MIX_WIDTH),
        "ffn2_norm": gain(ks[15], (D_MODEL,)),
        "ffn2_w_gate": nrm(ks[16], (D_MODEL, D_FF), D_MODEL),
        "ffn2_w_up": nrm(ks[17], (D_MODEL, D_FF), D_MODEL),
        "ffn2_w_down": nrm(ks[18], (D_FF, D_MODEL), D_FF),
    }


def reference(x, ffn1_norm, ffn1_w_gate, ffn1_w_up, ffn1_w_down, mix_norm, w_in, b_forget,
              pool_w, pool_scale, q_norm, k_norm, out_norm_pool, out_norm_attn, w_out,
              ffn2_norm, ffn2_w_gate, ffn2_w_up, ffn2_w_down):
    B, S, _ = x.shape
    for _layer in range(DEPTH):
        x = x + 0.5 * swiglu(rmsnorm(x, ffn1_norm), ffn1_w_gate, ffn1_w_up, ffn1_w_down)

        h = rmsnorm(x, mix_norm) @ w_in
        c0 = POOL_WIDTH
        pv = h[..., :c0]
        q = h[..., c0:c0 + ATTN_WIDTH].reshape(B, S, N_HEADS, HEAD_DIM)
        k = h[..., c0 + ATTN_WIDTH:c0 + 2 * ATTN_WIDTH].reshape(B, S, N_HEADS, HEAD_DIM)
        v = h[..., c0 + 2 * ATTN_WIDTH:c0 + 3 * ATTN_WIDTH].reshape(B, S, N_HEADS, HEAD_DIM)
        f_logit = h[..., c0 + 3 * ATTN_WIDTH:]

        y_pool = rmsnorm(pool_mixer(pv, pool_w, pool_scale), out_norm_pool)
        y_attn = rmsnorm(forgetting_attention(q, k, v, f_logit, b_forget, q_norm, k_norm), out_norm_attn)
        x = x + jnp.concatenate([y_pool, y_attn], axis=-1) @ w_out

        x = x + 0.5 * swiglu(rmsnorm(x, ffn2_norm), ffn2_w_gate, ffn2_w_up, ffn2_w_down)
    return x
```

```cpp
#include <hip/hip_runtime.h>
#include <cstdio>
#include <cstdint>
namespace pg8 {
#define PG8_LAS __attribute__((address_space(3)))
typedef unsigned short bf16_t;
typedef short bf16x8 __attribute__((ext_vector_type(8)));
typedef float f32x4 __attribute__((ext_vector_type(4)));
typedef unsigned u32x4 __attribute__((ext_vector_type(4)));
constexpr int BM = 256, BK = 64, HALF = 128, HTB = HALF * BK * 2  , STAGE_BYTES = 8 * HTB, NXCD = 8, WGM = 4;

__host__ __device__ __forceinline__ int lds_byte(int r, int c) { const int st = (r >> 4) * 2 + (c >> 5), rr = r & 15, cc = c & 31, ob = rr * 64 + cc * 2; return st * 1024 + (ob ^ (((ob >> 9) & 1) << 5)); }
__host__ __device__ __forceinline__ void stage_rc(int b, int& R, int& C) { const int st = b / 1024, sb = b % 1024, swz = sb ^ (((sb >> 9) & 1) << 5); R = (st >> 1) * 16 + swz / 64; C = (st & 1) * 32 + (swz % 64) / 2; }
__host__ __device__ __forceinline__ int perm32(int rho) { const int n = rho >> 4, i = rho & 15; return 8 * (i >> 2) + 4 * n + (i & 3); }

struct Unit { int pm, pn; };
struct Gemm { const bf16_t* A; const bf16_t* Bt; int M, N, K; };

struct StaticOrder {
    int nM, nN, nwg, G, c;
    __host__ __device__ void init(int M, int N, int G_, int c_) { nM = M / BM; nN = N / BM; nwg = nM * nN; G = G_; c = c_; }
    __host__ __device__ bool next(int i, Unit& u) const {
        const long L = (long)i * G + c; if (L >= nwg) return false;
        int wgid = (int)L; { const int q = nwg / NXCD, r = nwg % NXCD, xcd = wgid % NXCD, off = wgid / NXCD; wgid = (xcd < r ? xcd * (q + 1) : r * (q + 1) + (xcd - r) * q) + off; }
        const int nig = WGM * nN, gid = wgid / nig, fm = gid * WGM, gsz = (nM - fm) < WGM ? (nM - fm) : WGM;
        u.pm = fm + ((wgid % nig) % gsz); u.pn = (wgid % nig) / gsz; return true;
    }
    __device__ __forceinline__ void a_ready(const Unit&) const {}
    __device__ __forceinline__ void done(const Unit&) const {}
};

__device__ __forceinline__ unsigned cvt_pk_bf16(float lo, float hi) { unsigned r; asm volatile("v_cvt_pk_bf16_f32 %0, %1, %2" : "=v"(r) : "v"(lo), "v"(hi)); return r; }
typedef float f32x2 __attribute__((ext_vector_type(2)));
constexpr float RMS_EPS = 1e-6f;
__device__ __forceinline__ float rs_of(float sumsq) { return __builtin_amdgcn_rsqf(sumsq * (1.0f / 1024.0f) + RMS_EPS); }
__device__ __forceinline__ float row_rs(const float* stat, int row) { return rs_of(stat[row]); }
__device__ __forceinline__ void stat_preload(const float* stat, int pm, int wr, int lane, float (&pre)[2]) { pre[0] = stat[pm * BM + wr * 64 + lane]; pre[1] = stat[pm * BM + HALF + wr * 64 + lane]; }
__device__ __forceinline__ void tile_rs(const float (&pre)[2], int fr, float (&rs)[2][4]) {
    const float a0 = rs_of(pre[0]), a1 = rs_of(pre[1]);
#pragma unroll
    for (int m = 0; m < 4; ++m) { rs[0][m] = __shfl(a0, m * 16 + fr); rs[1][m] = __shfl(a1, m * 16 + fr); }
}
__device__ __forceinline__ float silu_mul(float g, float u) { return g * u * __builtin_amdgcn_rcpf(1.0f + __builtin_amdgcn_exp2f(g * -1.4426950408889634f)); }
struct SideXpose {
    const unsigned long long* tab;
    static constexpr int T_D = (2816 / 8) * 4, T_IN = (1024 / 8) * 6, T_O = (1024 / 8) * 4, T_GU = (1024 / 8) * 11, TOTAL = 2 * T_D + T_IN + T_O + 2 * T_GU;
    __device__ __forceinline__ void decode(int& r, const float*& W, int& ldw, int& K, int& ntiles, int& ncol0, const float*& gain, bf16_t*& WT, int& mode, int& kmin) const {
        int wi, gi, di; kmin = 0;
        if (r < T_D) { wi = 0; gi = -1; di = 8; ldw = 1024; K = 2816; ntiles = 4; ncol0 = 0; mode = 0; }
        else if ((r -= T_D) < T_IN) { wi = 1; gi = 6; di = 9; ldw = 2056; K = 1024; ntiles = 6; ncol0 = 512; mode = 3; }
        else if ((r -= T_IN) < T_O) { wi = 2; gi = 13; di = 10; ldw = 1024; K = 1024; ntiles = 4; ncol0 = 0; mode = 0; kmin = 512; }
        else if ((r -= T_O) < T_GU) { wi = 3; gi = 7; di = 11; ldw = 2816; K = 1024; ntiles = 11; ncol0 = 0; mode = 1; }
        else if ((r -= T_GU) < T_GU) { wi = 4; gi = 7; di = 11; ldw = 2816; K = 1024; ntiles = 11; ncol0 = 0; mode = 2; }
        else { r -= T_GU; wi = 5; gi = -1; di = 12; ldw = 1024; K = 2816; ntiles = 4; ncol0 = 0; mode = 0; }
        W = (const float*)tab[wi]; gain = gi >= 0 ? (const float*)tab[gi] : nullptr; WT = (bf16_t*)tab[di];
    }
};
template <bool SIDE> struct EpiGU {
    static constexpr bool PERM = true, AFTER_DRAIN = false, MIDK = false, PRELOAD = true;
    bf16_t* O; int ldo; const float* stat; SideXpose sx;
    __device__ __forceinline__ void preload(const Unit& u, int wr, int lane, float (&pre)[2]) const { stat_preload(stat, u.pm, wr, lane, pre); }
    __device__ __forceinline__ void operator()(const f32x4 (&acc)[2][2][4][2], const Unit& u, int wr, int wc, int fr, int fq, const float (&pre)[2]) const {
        const int row0 = u.pm * BM + wr * 64 + fr, col0 = u.pn * HALF + wc * 32 + 8 * fq;
        int sr = ((u.pn * 128 + u.pm) << 3) + wr * 4 + wc; const bool has = SIDE && sr < SideXpose::TOTAL;
        const float* sW = nullptr; const float* sgain = nullptr; bf16_t* sWT = nullptr; int sldw = 0, sK = 0, snt = 1, sn0 = 0, smode = 0, sk0 = 0, sn = 0, skmin = 0;
        f32x4 sv[8];
        if (has) { sx.decode(sr, sW, sldw, sK, snt, sn0, sgain, sWT, smode, skmin);
            const int per = 8 * snt, kb = sr / per, rem = sr % per; sk0 = kb * 64 + (rem & 7) * 8; sn = sn0 + (rem >> 3) * 256 + 4 * (fq * 16 + fr);
#pragma unroll
            for (int i = 0; i < 8; ++i) sv[i] = __builtin_nontemporal_load((const f32x4*)(sW + (size_t)(sk0 + i) * sldw + sn)); }
        float rsv[2][4]; tile_rs(pre, fr, rsv);
#pragma unroll
        for (int ai = 0; ai < 2; ++ai)
#pragma unroll
            for (int m = 0; m < 4; ++m) { const int row = row0 + ai * HALF + m * 16; const float rs = rsv[ai][m];
                const float c1 = rs * -1.4426950408889634f, k = __builtin_amdgcn_rcpf(rs * rs);
                const f32x4 t0 = acc[ai][0][m][0] * c1, t1 = acc[ai][0][m][1] * c1, p0 = acc[ai][0][m][0] * acc[ai][1][m][0], p1 = acc[ai][0][m][1] * acc[ai][1][m][1];
                float o[8];
#pragma unroll
                for (int e = 0; e < 4; ++e) { o[e] = p0[e] * __builtin_amdgcn_rcpf(__builtin_fmaf(__builtin_amdgcn_exp2f(t0[e]), k, k)); o[4 + e] = p1[e] * __builtin_amdgcn_rcpf(__builtin_fmaf(__builtin_amdgcn_exp2f(t1[e]), k, k)); }
                u32x4 w; w.x = cvt_pk_bf16(o[0], o[1]); w.y = cvt_pk_bf16(o[2], o[3]); w.z = cvt_pk_bf16(o[4], o[5]); w.w = cvt_pk_bf16(o[6], o[7]);
                __builtin_nontemporal_store(w, (u32x4*)(O + (size_t)row * ldo + col0)); }
        if (has) {
            if (sgain && sk0 >= skmin) {
#pragma unroll
                for (int i = 0; i < 8; ++i) sv[i] = sv[i] * sgain[sk0 + i]; }
            int drow = sn;
            if (smode == 1 || smode == 2) drow = 256 * (sn / 128) + (sn % 128) + (smode == 2 ? 128 : 0);
            if (smode == 3 && sn < 1536) drow = 256 * (sn / 256) + 128 * ((sn % 64) / 32) + 32 * ((sn % 256) / 64) + (sn % 32);
#pragma unroll
            for (int j = 0; j < 4; ++j) { u32x4 o; o.x = cvt_pk_bf16(sv[0][j], sv[1][j]); o.y = cvt_pk_bf16(sv[2][j], sv[3][j]); o.z = cvt_pk_bf16(sv[4][j], sv[5][j]); o.w = cvt_pk_bf16(sv[6][j], sv[7][j]);
                *(u32x4*)(sWT + (size_t)(drow + j) * sK + sk0) = o; }
        }
    }
};
template <bool OUTF32> struct EpiRes {
    static constexpr bool PERM = true, AFTER_DRAIN = false, MIDK = false, PRELOAD = false;
    float* out; bf16_t* xb; float* stat; float alpha;
    __device__ __forceinline__ void operator()(const f32x4 (&acc)[2][2][4][2], const Unit& u, int wr, int wc, int fr, int fq, const float (&pre)[2]) const {
        const int row0 = u.pm * BM + wr * 64 + fr, col0 = u.pn * BM + wc * 32 + 8 * fq;
#pragma unroll
        for (int ai = 0; ai < 2; ++ai) {
        u32x4 rv[1][4][2];
#pragma unroll
            for (int m = 0; m < 4; ++m)
#pragma unroll
                for (int bj = 0; bj < 2; ++bj) rv[0][m][bj] = *(const u32x4*)(xb + (size_t)(row0 + ai * HALF + m * 16) * 1024 + col0 + bj * HALF);
            asm volatile("" ::: "memory");
#pragma unroll
            for (int m = 0; m < 4; ++m) { const int row = row0 + ai * HALF + m * 16; const size_t off = (size_t)row * 1024 + col0; float ss = 0.f;
#pragma unroll
                for (int bj = 0; bj < 2; ++bj) { const u32x4 r = rv[0][m][bj];
                    const f32x4 b0 = (f32x4){__uint_as_float(r.x << 16), __uint_as_float(r.x & 0xffff0000u), __uint_as_float(r.y << 16), __uint_as_float(r.y & 0xffff0000u)};
                    const f32x4 b1 = (f32x4){__uint_as_float(r.z << 16), __uint_as_float(r.z & 0xffff0000u), __uint_as_float(r.w << 16), __uint_as_float(r.w & 0xffff0000u)};
                    const f32x4 o0 = b0 + acc[ai][bj][m][0] * alpha, o1 = b1 + acc[ai][bj][m][1] * alpha;
                    if (OUTF32) { __builtin_nontemporal_store(o0, (f32x4*)(out + off + bj * HALF)); __builtin_nontemporal_store(o1, (f32x4*)(out + off + bj * HALF + 4)); }
                    else { u32x4 w; w.x = cvt_pk_bf16(o0[0], o0[1]); w.y = cvt_pk_bf16(o0[2], o0[3]); w.z = cvt_pk_bf16(o1[0], o1[1]); w.w = cvt_pk_bf16(o1[2], o1[3]);
                        *(u32x4*)(xb + off + bj * HALF) = w;
                        ss += ((o0[0] * o0[0] + o0[1] * o0[1]) + (o0[2] * o0[2] + o0[3] * o0[3])) + ((o1[0] * o1[0] + o1[1] * o1[1]) + (o1[2] * o1[2] + o1[3] * o1[3])); } }
                if (!OUTF32) { ss += __shfl_xor(ss, 16); ss += __shfl_xor(ss, 32); if (fq == 0) unsafeAtomicAdd(stat + row, ss); } }
        }
    }
};
struct EpiOut {
    static constexpr bool PERM = true, AFTER_DRAIN = false, MIDK = true, PRELOAD = true;
    bf16_t* xb; float* stat; const float* ss;
    __device__ __forceinline__ void preload(const Unit& u, int wr, int lane, float (&pre)[2]) const { stat_preload(ss, u.pm, wr, lane, pre); }
    __device__ __forceinline__ void scales(const float (&pre)[2], int lane, bool inv, float (&sc)[2][4]) const {
        const float m0 = sqrtf(pre[0] * (1.0f / 512.0f) + RMS_EPS), m1 = sqrtf(pre[1] * (1.0f / 512.0f) + RMS_EPS);
        const float a0 = inv ? m0 : 1.0f / m0, a1 = inv ? m1 : 1.0f / m1; const int fr = lane & 15;
#pragma unroll
        for (int m = 0; m < 4; ++m) { sc[0][m] = __shfl(a0, m * 16 + fr); sc[1][m] = __shfl(a1, m * 16 + fr); }
    }
    __device__ __forceinline__ void midk(f32x4 (&acc)[2][2][4][2], const float (&pre)[2], int lane) const {
        float sc[2][4]; scales(pre, lane, true, sc);
#pragma unroll
        for (int ai = 0; ai < 2; ++ai)
#pragma unroll
            for (int bj = 0; bj < 2; ++bj)
#pragma unroll
                for (int m = 0; m < 4; ++m)
#pragma unroll
                    for (int n = 0; n < 2; ++n) acc[ai][bj][m][n] = acc[ai][bj][m][n] * sc[ai][m];
    }
    __device__ __forceinline__ void operator()(const f32x4 (&acc)[2][2][4][2], const Unit& u, int wr, int wc, int fr, int fq, const float (&pre)[2]) const {
        const int row0 = u.pm * BM + wr * 64 + fr, col0 = u.pn * BM + wc * 32 + 8 * fq;
        float sc[2][4]; scales(pre, fq * 16 + fr, false, sc);
#pragma unroll
        for (int ai = 0; ai < 2; ++ai) {
        u32x4 rv[4][2];
#pragma unroll
            for (int m = 0; m < 4; ++m)
#pragma unroll
                for (int bj = 0; bj < 2; ++bj) rv[m][bj] = *(const u32x4*)(xb + (size_t)(row0 + ai * HALF + m * 16) * 1024 + col0 + bj * HALF);
            asm volatile("" ::: "memory");
#pragma unroll
            for (int m = 0; m < 4; ++m) { const int row = row0 + ai * HALF + m * 16; const size_t off = (size_t)row * 1024 + col0; float ss_ = 0.f; const float s = sc[ai][m];
#pragma unroll
                for (int bj = 0; bj < 2; ++bj) { const u32x4 r = rv[m][bj];
                    const f32x4 b0 = (f32x4){__uint_as_float(r.x << 16), __uint_as_float(r.x & 0xffff0000u), __uint_as_float(r.y << 16), __uint_as_float(r.y & 0xffff0000u)};
                    const f32x4 b1 = (f32x4){__uint_as_float(r.z << 16), __uint_as_float(r.z & 0xffff0000u), __uint_as_float(r.w << 16), __uint_as_float(r.w & 0xffff0000u)};
                    const f32x4 o0 = b0 + acc[ai][bj][m][0] * s, o1 = b1 + acc[ai][bj][m][1] * s;
                    u32x4 w; w.x = cvt_pk_bf16(o0[0], o0[1]); w.y = cvt_pk_bf16(o0[2], o0[3]); w.z = cvt_pk_bf16(o1[0], o1[1]); w.w = cvt_pk_bf16(o1[2], o1[3]);
                    *(u32x4*)(xb + off + bj * HALF) = w;
                    ss_ += ((o0[0] * o0[0] + o0[1] * o0[1]) + (o0[2] * o0[2] + o0[3] * o0[3])) + ((o1[0] * o1[0] + o1[1] * o1[1]) + (o1[2] * o1[2] + o1[3] * o1[3])); }
                ss_ += __shfl_xor(ss_, 16); ss_ += __shfl_xor(ss_, 32); if (fq == 0) unsafeAtomicAdd(stat + row, ss_); }
        }
    }
};
struct EpiIn {
    static constexpr bool PERM = true, AFTER_DRAIN = false, MIDK = false, PRELOAD = true;
    bf16_t* H; const float* stat; const float* qg; const float* kg; float qscale;
    __device__ __forceinline__ void preload(const Unit& u, int wr, int lane, float (&pre)[2]) const { stat_preload(stat, u.pm, wr, lane, pre); }
    __device__ __forceinline__ void operator()(const f32x4 (&acc)[2][2][4][2], const Unit& u, int wr, int wc, int fr, int fq, const float (&pre)[2]) const {
        const int row0 = u.pm * BM + wr * 64 + fr; const int pn = u.pn; const bool hp = (pn >= 2 && pn < 6);
        float rsv[2][4]; tile_rs(pre, fr, rsv);
        if (!hp) { const int col0 = pn * BM + wc * 32 + 8 * fq;
#pragma unroll
            for (int ai = 0; ai < 2; ++ai)
#pragma unroll
                for (int m = 0; m < 4; ++m) { const int row = row0 + ai * HALF + m * 16; const float rs = rsv[ai][m];
#pragma unroll
                    for (int bj = 0; bj < 2; ++bj) { const f32x4 v0 = acc[ai][bj][m][0] * rs, v1 = acc[ai][bj][m][1] * rs;
                        u32x4 w; w.x = cvt_pk_bf16(v0[0], v0[1]); w.y = cvt_pk_bf16(v0[2], v0[3]); w.z = cvt_pk_bf16(v1[0], v1[1]); w.w = cvt_pk_bf16(v1[2], v1[3]);
                        *(u32x4*)(H + (size_t)row * 2048 + col0 + bj * HALF) = w; } }
        } else { const float* g = (pn < 4) ? qg : kg; const float sc = (pn < 4) ? qscale : 1.0f; const int col0 = pn * BM + wc * 64 + 8 * fq;
            f32x4 gv[2][2];
#pragma unroll
            for (int bj = 0; bj < 2; ++bj)
#pragma unroll
                for (int n = 0; n < 2; ++n) gv[bj][n] = *(const f32x4*)(g + 32 * bj + 8 * fq + 4 * n) * sc;
#pragma unroll
            for (int ai = 0; ai < 2; ++ai)
#pragma unroll
                for (int m = 0; m < 4; ++m) { const int row = row0 + ai * HALF + m * 16; const float rs = rsv[ai][m];
                    f32x4 v[2][2]; float ss = 0.f;
#pragma unroll
                    for (int bj = 0; bj < 2; ++bj)
#pragma unroll
                        for (int n = 0; n < 2; ++n) { v[bj][n] = acc[ai][bj][m][n] * rs; const f32x4 x = v[bj][n]; ss += (x[0] * x[0] + x[1] * x[1]) + (x[2] * x[2] + x[3] * x[3]); }
                    ss += __shfl_xor(ss, 16); ss += __shfl_xor(ss, 32);
                    const float r = 1.0f / sqrtf(ss * (1.0f / 64.0f) + RMS_EPS);
#pragma unroll
                    for (int bj = 0; bj < 2; ++bj) { const f32x4 v0 = v[bj][0] * r * gv[bj][0], v1 = v[bj][1] * r * gv[bj][1];
                        u32x4 w; w.x = cvt_pk_bf16(v0[0], v0[1]); w.y = cvt_pk_bf16(v0[2], v0[3]); w.z = cvt_pk_bf16(v1[0], v1[1]); w.w = cvt_pk_bf16(v1[2], v1[3]);
                        *(u32x4*)(H + (size_t)row * 2048 + col0 + bj * 32) = w; } }
        }
    }
};
template <class Epi, class Sched, bool ALIGN_EPI = false, bool SP2 = false>
__device__ __forceinline__ void gemm_phase(PG8_LAS unsigned char* lds, const Gemm g, const Sched& S, const Epi& E) {
    int tid_ = threadIdx.x; asm volatile("" : "+v"(tid_));
    const int tid = tid_, wid = __builtin_amdgcn_readfirstlane(tid >> 6), lane = tid & 63, wr = wid >> 2, wc = wid & 3, fr = lane & 15, fq = lane >> 4;
    const int K = g.K, nt = K / BK;
    unsigned voffA[2], voffB[2];
#pragma unroll
    for (int i = 0; i < 2; ++i) { int R, C; stage_rc(tid * 16 + i * 8192, R, C); const int Rb = Epi::PERM ? ((R & ~31) + perm32(R & 31)) : R;
        voffA[i] = (unsigned)(R * K + C) * 2u; voffB[i] = (unsigned)(Rb * K + C) * 2u; }
    const size_t kstep = (size_t)(BK * 2);
    const size_t hstep = (size_t)HALF * K * 2;
    const size_t tstep = 2 * hstep;
    const unsigned ldsw = (unsigned)wid * 1024u;
    const int aoff = lds_byte(wr * 64 + fr, fq * 8), boff = lds_byte(wc * 32 + fr, fq * 8);
#define PG8_SA(b, h) (((b) * 2 + (h)) * HTB)
#define PG8_SB(b, h) ((4 + (b) * 2 + (h)) * HTB)
#define PG8_STAGE(bufoff, gbase, voff) do { _Pragma("unroll") for (int _i = 0; _i < 2; ++_i) \
        __builtin_amdgcn_global_load_lds((const unsigned*)((const char*)(gbase) + (voff)[_i]), (PG8_LAS unsigned*)(lds + (bufoff) + ldsw + _i * 8192), 16, 0, 0); } while (0)
#define PG8_LDA(dst, b, h) do { _Pragma("unroll") for (int m = 0; m < 4; ++m) _Pragma("unroll") for (int k = 0; k < 2; ++k) dst[m][k] = *(const PG8_LAS bf16x8*)(lds + PG8_SA(b, h) + aoff + m * 2048 + k * 1024); } while (0)
#define PG8_LDB(dst, b, h) do { _Pragma("unroll") for (int n = 0; n < 2; ++n) _Pragma("unroll") for (int k = 0; k < 2; ++k) dst[n][k] = *(const PG8_LAS bf16x8*)(lds + PG8_SB(b, h) + boff + n * 2048 + k * 1024); } while (0)
#define PG8_MMA(ai, bj, At, Bt) do { __builtin_amdgcn_s_setprio(1); _Pragma("unroll") for (int m = 0; m < 4; ++m) _Pragma("unroll") for (int n = 0; n < 2; ++n) _Pragma("unroll") for (int k = 0; k < 2; ++k) \
        acc[ai][bj][m][n] = __builtin_amdgcn_mfma_f32_16x16x32_bf16(Bt[n][k], At[m][k], acc[ai][bj][m][n], 0, 0, 0); __builtin_amdgcn_s_setprio(0); } while (0)
#define PG8_WAIT_V(n) asm volatile("s_waitcnt vmcnt(" #n ")" ::: "memory")
#define PG8_WAIT_L(n) asm volatile("s_waitcnt lgkmcnt(" #n ")" ::: "memory")
#define PG8_BAR __builtin_amdgcn_s_barrier()
#define PG8_SCHED __builtin_amdgcn_sched_barrier(0)
    Unit cur, nxt; int ui = 0;
    if (!S.next(0, cur)) return;
    f32x4 acc[2][2][4][2];
#pragma unroll
    for (int a = 0; a < 2; ++a)
#pragma unroll
        for (int b = 0; b < 2; ++b)
#pragma unroll
            for (int m = 0; m < 4; ++m)
#pragma unroll
                for (int n = 0; n < 2; ++n) acc[a][b][m][n] = (f32x4){0.f, 0.f, 0.f, 0.f};
    bf16x8 At[4][2], B0[2][2], B1[2][2];
    const char* cA = (const char*)g.A + (size_t)cur.pm * tstep; const char* cB = (const char*)g.Bt + (size_t)cur.pn * tstep;
    float pre[2] = {0.f, 0.f};
    if constexpr (Epi::PRELOAD) E.preload(cur, wr, lane, pre);
    S.a_ready(cur);
    if constexpr (SP2) {
        PG8_STAGE(PG8_SB(0, 0), cB, voffB); PG8_STAGE(PG8_SB(0, 1), cB + hstep, voffB); PG8_STAGE(PG8_SA(0, 0), cA, voffA); PG8_STAGE(PG8_SA(0, 1), cA + hstep, voffA);
        if (wr == 1) PG8_BAR;
        PG8_WAIT_V(2); PG8_BAR;
        PG8_STAGE(PG8_SB(1, 0), cB + kstep, voffB); PG8_STAGE(PG8_SA(1, 0), cA + kstep, voffA); PG8_STAGE(PG8_SB(1, 1), cB + hstep + kstep, voffB);
        PG8_WAIT_V(6); PG8_BAR;
    } else {
        PG8_STAGE(PG8_SB(0, 0), cB, voffB); PG8_STAGE(PG8_SA(0, 0), cA, voffA); PG8_STAGE(PG8_SB(0, 1), cB + hstep, voffB); PG8_STAGE(PG8_SA(0, 1), cA + hstep, voffA);
        if (wr == 1) PG8_BAR;
        PG8_WAIT_V(4); PG8_BAR;
        PG8_STAGE(PG8_SB(1, 0), cB + kstep, voffB); PG8_STAGE(PG8_SA(1, 0), cA + kstep, voffA); PG8_STAGE(PG8_SB(1, 1), cB + hstep + kstep, voffB);
        PG8_WAIT_V(6); PG8_BAR;
    }
    for (;;) {
        const bool has_next = S.next(ui + 1, nxt);
        const char* nA = has_next ? (const char*)g.A + (size_t)nxt.pm * tstep : cA; const char* nB = has_next ? (const char*)g.Bt + (size_t)nxt.pn * tstep : cB;
        for (int t = 0; t < nt; t += 2) {
            if constexpr (Epi::MIDK) { if (t == nt / 2) E.midk(acc, pre, lane); }
            const bool last = (t == nt - 2);
            const char* a1 = cA + (size_t)(t + 1) * kstep;
            const char* a2 = last ? nA : cA + (size_t)(t + 2) * kstep; const char* b2 = last ? nB : cB + (size_t)(t + 2) * kstep;
            const char* a3 = a2 + kstep; const char* b3 = b2 + kstep;
            if (last && has_next) S.a_ready(nxt);
            if constexpr (SP2) {
            PG8_LDB(B0, 0, 0); PG8_LDB(B1, 0, 1); PG8_SCHED; PG8_LDA(At, 0, 0); PG8_STAGE(PG8_SA(1, 1), a1 + hstep, voffA);
            PG8_WAIT_V(8); PG8_WAIT_L(0); PG8_BAR; PG8_MMA(0, 0, At, B0); PG8_MMA(0, 1, At, B1); PG8_BAR; PG8_SCHED;
            PG8_LDA(At, 0, 1); PG8_STAGE(PG8_SB(0, 0), b2, voffB); PG8_STAGE(PG8_SB(0, 1), b2 + hstep, voffB); PG8_STAGE(PG8_SA(0, 0), a2, voffA);
            PG8_WAIT_V(8); PG8_WAIT_L(0); PG8_BAR; PG8_MMA(1, 0, At, B0); PG8_MMA(1, 1, At, B1); PG8_BAR; PG8_SCHED;
            PG8_LDB(B0, 1, 0); PG8_LDB(B1, 1, 1); PG8_SCHED; PG8_LDA(At, 1, 0); PG8_STAGE(PG8_SA(0, 1), a2 + hstep, voffA);
            PG8_WAIT_V(8); PG8_WAIT_L(0); PG8_BAR; PG8_MMA(0, 0, At, B0); PG8_MMA(0, 1, At, B1); PG8_BAR; PG8_SCHED;
            PG8_LDA(At, 1, 1); PG8_STAGE(PG8_SB(1, 0), b3, voffB); PG8_STAGE(PG8_SB(1, 1), b3 + hstep, voffB); PG8_STAGE(PG8_SA(1, 0), a3, voffA);
            PG8_WAIT_V(8); PG8_WAIT_L(0); PG8_BAR; PG8_MMA(1, 0, At, B0); PG8_MMA(1, 1, At, B1); PG8_BAR; PG8_SCHED;
            } else {
            PG8_LDB(B0, 0, 0); PG8_SCHED; PG8_LDA(At, 0, 0); PG8_STAGE(PG8_SA(1, 1), a1 + hstep, voffA);
            PG8_WAIT_L(8); PG8_BAR; PG8_WAIT_L(0); PG8_MMA(0, 0, At, B0); PG8_BAR; PG8_SCHED;
            PG8_LDB(B1, 0, 1); PG8_STAGE(PG8_SB(0, 0), b2, voffB);
            PG8_BAR; PG8_WAIT_L(0); PG8_MMA(0, 1, At, B1); PG8_BAR;
            PG8_LDA(At, 0, 1); PG8_STAGE(PG8_SA(0, 0), a2, voffA);
            PG8_BAR; PG8_WAIT_L(0); PG8_MMA(1, 0, At, B0); PG8_BAR; PG8_SCHED;
            PG8_STAGE(PG8_SB(0, 1), b2 + hstep, voffB);
            PG8_WAIT_V(6); PG8_BAR; PG8_MMA(1, 1, At, B1); PG8_BAR;
            PG8_LDB(B0, 1, 0); PG8_SCHED; PG8_LDA(At, 1, 0); PG8_STAGE(PG8_SA(0, 1), a2 + hstep, voffA);
            PG8_WAIT_L(8); PG8_BAR; PG8_WAIT_L(0); PG8_MMA(0, 0, At, B0); PG8_BAR; PG8_SCHED;
            PG8_LDB(B1, 1, 1); PG8_STAGE(PG8_SB(1, 0), b3, voffB);
            PG8_BAR; PG8_WAIT_L(0); PG8_MMA(0, 1, At, B1); PG8_BAR;
            PG8_LDA(At, 1, 1); PG8_STAGE(PG8_SA(1, 0), a3, voffA);
            PG8_BAR; PG8_WAIT_L(0); PG8_MMA(1, 0, At, B0); PG8_BAR; PG8_SCHED;
            PG8_STAGE(PG8_SB(1, 1), b3 + hstep, voffB);
            PG8_WAIT_V(6); PG8_BAR; PG8_MMA(1, 1, At, B1); PG8_BAR;
            }
        }
        if constexpr (ALIGN_EPI) { if (wr == 0) PG8_BAR; }
        if constexpr (!Epi::AFTER_DRAIN) { E(acc, cur, wr, wc, fr, fq, pre); S.done(cur); }
        if (!has_next) break;
#pragma unroll
        for (int a = 0; a < 2; ++a)
#pragma unroll
            for (int b = 0; b < 2; ++b)
#pragma unroll
                for (int m = 0; m < 4; ++m)
#pragma unroll
                    for (int n = 0; n < 2; ++n) acc[a][b][m][n] = (f32x4){0.f, 0.f, 0.f, 0.f};
        cur = nxt; cA = nA; cB = nB; ++ui;
        if constexpr (Epi::PRELOAD) E.preload(cur, wr, lane, pre);
        if constexpr (ALIGN_EPI) { if (wr == 1) PG8_BAR; }
    }
    PG8_WAIT_V(0);
    if constexpr (!ALIGN_EPI) { if (wr == 0) PG8_BAR; }
    PG8_BAR;
    if constexpr (Epi::AFTER_DRAIN) { E.fused(acc, cur, wr, wc, fr, fq, lds, wid, lane); S.done(cur); }
#undef PG8_SA
#undef PG8_SB
#undef PG8_STAGE
#undef PG8_LDA
#undef PG8_LDB
#undef PG8_MMA
#undef PG8_WAIT_V
#undef PG8_WAIT_L
#undef PG8_BAR
#undef PG8_SCHED
}
}

#ifndef PG8_SP2
#define PG8_SP2 true
#endif
#ifndef PG8_ALIGN
#define PG8_ALIGN true
#endif
#include <hip/hip_bf16.h>
#include <cmath>
namespace attn_body {
using bf16=__hip_bfloat16;
using bf16x8=__attribute__((ext_vector_type(8)))short;
using s16x4=__attribute__((ext_vector_type(4)))short;
using f32x16=__attribute__((ext_vector_type(16)))float;
using u32x4=__attribute__((ext_vector_type(4)))unsigned;
constexpr int BATCH=16,NHEAD=8,SEQ=2048,D=64,QPITCH=2048,OPITCH=1024;
constexpr int NW=8,QBLK=32,QB=QBLK*NW,KVBLK=64,NQB=SEQ/QB;
constexpr int ATTN_UNIT_ROWS=QB;
__device__ __forceinline__ int crow(int r,int hi){return (r&3)+8*(r>>2)+4*hi;}
#define SBAR() __builtin_amdgcn_sched_barrier(0)
__device__ __forceinline__ void cmask(f32x16&p0,f32x16&p1,int jb,int qrel,int hi){
  const float NEG=-INFINITY; int kb=64*jb+4*hi;
  #pragma unroll
  for(int r=0;r<16;++r){int kv=kb+(r&3)+8*(r>>2); if(kv>qrel)p0[r]=NEG; if(kv+32>qrel)p1[r]=NEG;}
}

constexpr int NSLOT=3, SLOTB=8192;
constexpr int LDS_K=0, LDS_V=NSLOT*SLOTB, LDS_WS=2*NSLOT*SLOTB, LDS_OST=LDS_WS+NW*64*4, LDS_BYTES=LDS_OST+NW*4096;
constexpr float C2=0.125f*1.4426950408889634f;
__device__ __forceinline__ void glds16(const void*gsrc,unsigned lds_dst){unsigned keep;
  asm volatile("s_mov_b32 %0, m0\n\ts_mov_b32 m0, %2\n\ts_nop 0\n\tglobal_load_lds_dwordx4 %1, off\n\ts_mov_b32 m0, %0":"=&s"(keep):"v"(gsrc),"s"(lds_dst):"memory");}
__device__ __forceinline__ float max3f(float a,float b,float c){float r;asm("v_max3_f32 %0, %1, %2, %3":"=v"(r):"v"(a),"v"(b),"v"(c));return r;}
__device__ __forceinline__ float max2f(float a,float b){float r;asm("v_max_f32_e32 %0, %1, %2":"=v"(r):"v"(a),"v"(b));return r;}
__device__ __forceinline__ float fadd_s(float a,float b){float r;asm("v_add_f32_e32 %0, %1, %2":"=v"(r):"v"(a),"v"(b));return r;}
__device__ __forceinline__ float fsub_s(float a,float b){float r;asm("v_sub_f32_e32 %0, %1, %2":"=v"(r):"v"(a),"v"(b));return r;}
typedef float f32x2_t __attribute__((ext_vector_type(2))); typedef __bf16 bf16x2_t __attribute__((ext_vector_type(2)));
__device__ __forceinline__ unsigned cvtpk_s(float lo,float hi){f32x2_t v={lo,hi};bf16x2_t b=__builtin_convertvector(v,bf16x2_t);return __builtin_bit_cast(unsigned,b);}
#define WAIT_BAR(N) asm volatile("s_waitcnt vmcnt(" #N ") lgkmcnt(0)\n\ts_barrier":::"memory")

__device__ __forceinline__ void qkt(f32x16&p0,f32x16&p1,const char*Kslot,const bf16x8*qr,int r32,int hi){
  const char*kb=Kslot+hi*1024+r32*16;
  #pragma unroll
  for(int d0=0;d0<4;++d0){
    const bf16x8 b0=*reinterpret_cast<const bf16x8*>(kb+d0*2048);
    const bf16x8 b1=*reinterpret_cast<const bf16x8*>(kb+d0*2048+512);
    p0=__builtin_amdgcn_mfma_f32_32x32x16_bf16(b0,qr[d0],p0,0,0,0);p1=__builtin_amdgcn_mfma_f32_32x32x16_bf16(b1,qr[d0],p1,0,0,0);}
}
typedef __attribute__((address_space(3))) const char* lds_cptr;
typedef short v4i16_t __attribute__((ext_vector_type(4)));
__device__ __forceinline__ void kload8(bf16x8*kf,lds_cptr kp){
  kf[0]=*(const __attribute__((address_space(3))) bf16x8*)(kp);      kf[1]=*(const __attribute__((address_space(3))) bf16x8*)(kp+512);
  kf[2]=*(const __attribute__((address_space(3))) bf16x8*)(kp+2048); kf[3]=*(const __attribute__((address_space(3))) bf16x8*)(kp+2560);
  kf[4]=*(const __attribute__((address_space(3))) bf16x8*)(kp+4096); kf[5]=*(const __attribute__((address_space(3))) bf16x8*)(kp+4608);
  kf[6]=*(const __attribute__((address_space(3))) bf16x8*)(kp+6144); kf[7]=*(const __attribute__((address_space(3))) bf16x8*)(kp+6656);
}
__device__ __forceinline__ void kload2(bf16x8*kf,lds_cptr kp,int j){ kf[2*j]=*(const __attribute__((address_space(3))) bf16x8*)(kp+j*2048); kf[2*j+1]=*(const __attribute__((address_space(3))) bf16x8*)(kp+j*2048+512); }
__device__ __forceinline__ s16x4 vtr(lds_cptr p){ return __builtin_bit_cast(s16x4,__builtin_amdgcn_ds_read_tr16_b64_v4i16((__attribute__((address_space(3))) v4i16_t*)p)); }
__device__ __forceinline__ float rowmax(const f32x16&p0,const f32x16&p1){
  float a=max3f(p0[0],p0[1],p1[0]),b=max3f(p0[2],p0[3],p1[1]);a=max3f(a,p1[2],p1[3]);
  #pragma unroll
  for(int r=4;r<16;r+=4){a=max3f(a,p0[r],p0[r+1]);b=max3f(b,p0[r+2],p0[r+3]);a=max3f(a,p1[r],p1[r+1]);b=max3f(b,p1[r+2],p1[r+3]);}
  const float m=max2f(a,b);
  auto rr=__builtin_amdgcn_permlane32_swap(__float_as_uint(m),__float_as_uint(m),false,false);
  return max2f(__uint_as_float(rr[0]),__uint_as_float(rr[1]));
}
__device__ __forceinline__ void pv(f32x16*o,int vb,bf16x8 pa0,bf16x8 pa1,bf16x8 pa2,bf16x8 pa3){
  #pragma unroll
  for(int d0=0;d0<2;++d0){s16x4 lo[4],hi[4];
    #pragma unroll
    for(int ks=0;ks<4;++ks){
      asm volatile("ds_read_b64_tr_b16 %0,%1 offset:%c2":"=&v"(lo[ks]):"v"(vb),"i"(d0*4096+ks*1024):"memory");
      asm volatile("ds_read_b64_tr_b16 %0,%1 offset:%c2":"=&v"(hi[ks]):"v"(vb),"i"(d0*4096+ks*1024+512):"memory");}
    asm volatile("s_waitcnt lgkmcnt(0)":::"memory");SBAR();
    #define PK(k) (bf16x8){lo[k][0],lo[k][1],lo[k][2],lo[k][3],hi[k][0],hi[k][1],hi[k][2],hi[k][3]}
    o[d0]=__builtin_amdgcn_mfma_f32_32x32x16_bf16(pa0,PK(0),o[d0],0,0,0);
    o[d0]=__builtin_amdgcn_mfma_f32_32x32x16_bf16(pa1,PK(1),o[d0],0,0,0);
    o[d0]=__builtin_amdgcn_mfma_f32_32x32x16_bf16(pa2,PK(2),o[d0],0,0,0);
    o[d0]=__builtin_amdgcn_mfma_f32_32x32x16_bf16(pa3,PK(3),o[d0],0,0,0);
    #undef PK
  }
}

#ifndef ATTN_STORE16
#define ATTN_STORE16(p,v) (*(u32x4*)(p)=(v))
#endif
template<int THRL> __device__ __forceinline__ void attn_unit(int b,int h,int qb,const bf16*Q,const bf16*__restrict__ K,const bf16*__restrict__ V,bf16*O,char*shm,const __attribute__((address_space(3))) float*F2,const float REF,float*SS){
  int tid_=threadIdx.x; asm volatile("":"+v"(tid_)); const int tid=tid_,lane=tid&63,r32=lane&31,hi=lane>>5; const int wid=__builtin_amdgcn_readfirstlane(tid>>6);
  const long rowbase=(long)b*SEQ; const int q0=qb*QB;
  const bf16*Qw=Q+(rowbase+q0+wid*QBLK)*QPITCH+h*D;
  const bf16*Kh=K+rowbase*QPITCH+h*D,*Vh=V+rowbase*QPITCH+h*D;
  const unsigned lds0=(unsigned)(uintptr_t)shm;
  float*wsf=(float*)(shm+LDS_WS)+wid*64;
  const bf16*ksrc=Kh+(long)lane*QPITCH+wid*8;
  const bf16*vsrc=Vh+(long)(16*(wid&3)+(lane>>2))*QPITCH+(wid>>2)*32+(lane&3)*8;
  const unsigned kdst=lds0+LDS_K+wid*1024, vdst=lds0+LDS_V+wid*1024;
  #define DMA_K(t,slot) glds16(ksrc+(long)(t)*KVBLK*QPITCH,(unsigned)__builtin_amdgcn_readfirstlane(kdst+(slot)))
  #define DMA_V(t,slot) glds16(vsrc+(long)(t)*KVBLK*QPITCH,(unsigned)__builtin_amdgcn_readfirstlane(vdst+(slot)))
  const int vb0=(int)(lds0+LDS_V)+((lane>>4)&1)*32+(lane&3)*8+(4*hi+((lane&15)>>2))*64;
  const char*Kbase=shm+LDS_K; bf16x8 kf[8];
  const lds_cptr shm3=(lds_cptr)shm; const lds_cptr kp0=shm3+LDS_K+hi*1024+r32*16; const lds_cptr vp0=shm3+LDS_V+((lane>>4)&1)*32+(lane&3)*8+(4*hi+((lane&15)>>2))*64;
  const int NT=(q0+QB)/KVBLK;
  DMA_K(0,0);DMA_V(0,0);DMA_K(1,SLOTB);
  bf16x8 qr[4];
  #pragma unroll
  for(int d0=0;d0<4;++d0)qr[d0]=*reinterpret_cast<const bf16x8*>(&Qw[(long)r32*QPITCH+d0*16+hi*8]);
  float l_reg=0.f;f32x16 o[2];o[0]=f32x16{};o[1]=f32x16{};
  const int qrel=wid*QBLK+r32;
  const float cq=F2[q0+qrel]-REF;
  typedef float f32x4b __attribute__((ext_vector_type(4)));
  #define CINIT(P0,P1,t) do{ const __attribute__((address_space(3))) float* fb_=F2+64*(t)+4*hi; const float nm_=cq; \
    _Pragma("unroll") for(int g_=0;g_<4;++g_){ const f32x4b a_=*(const __attribute__((address_space(3))) f32x4b*)(fb_+8*g_); const f32x4b b_=*(const __attribute__((address_space(3))) f32x4b*)(fb_+32+8*g_); \
      _Pragma("unroll") for(int i_=0;i_<4;++i_){ P0[4*g_+i_]=nm_-a_[i_]; P1[4*g_+i_]=nm_-b_[i_]; } SBAR(); } }while(0)
  #define CMASK(P0,P1,t) do{int jb_=(t)-(NT-4); if(jb_>=0)cmask(P0,P1,jb_,qrel,hi);}while(0)
  #define RESC() do{}while(0)
  f32x16 pA0,pA1,pB0,pB1;
  int sl_prev=0,sl_cur=0,sl_next=SLOTB;
  #define ROT() do{sl_prev=sl_cur;sl_cur=sl_next;sl_next=(sl_next==(NSLOT-1)*SLOTB)?0:sl_next+SLOTB;}while(0)
  DMA_K(2,2*SLOTB);
  WAIT_BAR(3);
  CINIT(pA0,pA1,0);qkt(pA0,pA1,Kbase,qr,r32,hi);asm volatile("s_nop 15\n\ts_nop 7":"+v"(pA0),"+v"(pA1));CMASK(pA0,pA1,0);
  _Pragma("unroll") for(int r=0;r<16;++r){pA0[r]=__builtin_amdgcn_exp2f(pA0[r]);pA1[r]=__builtin_amdgcn_exp2f(pA1[r]);}
  WAIT_BAR(0);
  DMA_K(3,0);DMA_V(1,SLOTB);
  ROT();
  kload8(kf,kp0+sl_cur);
  WAIT_BAR(2);
  s16x4 vlo[8],vhi[8]; u32x4 pw0,pw1,pw2,pw3;
  #define PKW(P,B) cvtpk_s(P[B],P[B+1])
  #define PAF(k) __builtin_bit_cast(bf16x8,pw##k)
  #define VFR(i) (bf16x8){vlo[i][0],vlo[i][1],vlo[i][2],vlo[i][3],vhi[i][0],vhi[i][1],vhi[i][2],vhi[i][3]}
  #define PIN(x) asm volatile("":"+v"(x))
  #define MX3(a,b,c) __builtin_fmaxf(__builtin_fmaxf((a),(b)),(c))
  #define GAPA(MF,A0,A1,A2,A3,W0,W1,PW) do{ MF; sacc+=A0; sacc+=A1; sacc+=A2; sacc+=A3; PIN(sacc); W0; W1; PIN(PW); SBAR(); }while(0)
  #define EX(v) __builtin_amdgcn_exp2f(v)
  #define GAPB(MF,X,B) do{ MF; X[B]=EX(X[B]); X[B+1]=EX(X[B+1]); X[B+2]=EX(X[B+2]); X[B+3]=EX(X[B+3]); PIN(X); SBAR(); }while(0)
  #define VRD(i) do{ vlo[i]=vtr(vp_+(((i)>>2)*4096+((i)&3)*1024)); vhi[i]=vtr(vp_+(((i)>>2)*4096+((i)&3)*1024+512)); }while(0)
  #define KRD(G,j) do{ if(G){ kload2(kf,kp0+sl_next,j); SBAR(); } }while(0)
  #define STEP(C0,C1,P0,P1,t,GK,GV,GL) do{ SBAR(); CINIT(C0,C1,t); SBAR(); \
    const lds_cptr vp_=vp0+sl_prev; \
    VRD(0); SBAR(); float sacc=(P0[0]+P0[1]); \
    GAPA(C0=__builtin_amdgcn_mfma_f32_32x32x16_bf16(kf[0],qr[0],C0,0,0,0), P0[2],P0[3],P0[4],P0[5],     pw0[0]=PKW(P0,0), pw0[1]=PKW(P0,2), pw0); \
    VRD(4); SBAR(); GAPA(C1=__builtin_amdgcn_mfma_f32_32x32x16_bf16(kf[1],qr[0],C1,0,0,0), P0[6],P0[7],P0[8],P0[9],     pw0[2]=PKW(P0,4), pw0[3]=PKW(P0,6), pw0); \
    VRD(1); SBAR(); GAPA(C0=__builtin_amdgcn_mfma_f32_32x32x16_bf16(kf[2],qr[1],C0,0,0,0),   P0[10],P0[11],P0[12],P0[13], pw1[0]=PKW(P0,8), pw1[1]=PKW(P0,10), pw1); \
    VRD(5); SBAR(); GAPA(C1=__builtin_amdgcn_mfma_f32_32x32x16_bf16(kf[3],qr[1],C1,0,0,0),   P0[14],P0[15],P1[0],P1[1],   pw1[2]=PKW(P0,12),pw1[3]=PKW(P0,14), pw1); \
    VRD(2); SBAR(); GAPA(C0=__builtin_amdgcn_mfma_f32_32x32x16_bf16(kf[4],qr[2],C0,0,0,0),   P1[2],P1[3],P1[4],P1[5],     pw2[0]=PKW(P1,0), pw2[1]=PKW(P1,2), pw2); \
    VRD(6); SBAR(); GAPA(C1=__builtin_amdgcn_mfma_f32_32x32x16_bf16(kf[5],qr[2],C1,0,0,0),   P1[6],P1[7],P1[8],P1[9],     pw2[2]=PKW(P1,4), pw2[3]=PKW(P1,6), pw2); \
    VRD(3); SBAR(); GAPA(C0=__builtin_amdgcn_mfma_f32_32x32x16_bf16(kf[6],qr[3],C0,0,0,0),   P1[10],P1[11],P1[12],P1[13], pw3[0]=PKW(P1,8), pw3[1]=PKW(P1,10), pw3); \
    VRD(7); SBAR(); GAPA(C1=__builtin_amdgcn_mfma_f32_32x32x16_bf16(kf[7],qr[3],C1,0,0,0),   P1[14],P1[15],0.f,0.f,       pw3[2]=PKW(P1,12),pw3[3]=PKW(P1,14), pw3); \
    l_reg+=sacc; \
    if(GK){DMA_K((t)+3,sl_cur);} if(GV){DMA_V((t)+1,sl_next);} \
    CMASK(C0,C1,t); \
    SBAR(); \
    GAPB(o[0]=__builtin_amdgcn_mfma_f32_32x32x16_bf16(PAF(0),VFR(0),o[0],0,0,0), C0,0); \
    GAPB(o[1]=__builtin_amdgcn_mfma_f32_32x32x16_bf16(PAF(0),VFR(4),o[1],0,0,0), C0,4); \
    KRD(GL,0); GAPB(o[0]=__builtin_amdgcn_mfma_f32_32x32x16_bf16(PAF(1),VFR(1),o[0],0,0,0), C0,8); \
    KRD(GL,1); GAPB(o[1]=__builtin_amdgcn_mfma_f32_32x32x16_bf16(PAF(1),VFR(5),o[1],0,0,0), C0,12); \
    KRD(GL,2); GAPB(o[0]=__builtin_amdgcn_mfma_f32_32x32x16_bf16(PAF(2),VFR(2),o[0],0,0,0), C1,0); \
    KRD(GL,3); GAPB(o[1]=__builtin_amdgcn_mfma_f32_32x32x16_bf16(PAF(2),VFR(6),o[1],0,0,0), C1,4); \
    GAPB(o[0]=__builtin_amdgcn_mfma_f32_32x32x16_bf16(PAF(3),VFR(3),o[0],0,0,0), C1,8); \
    GAPB(o[1]=__builtin_amdgcn_mfma_f32_32x32x16_bf16(PAF(3),VFR(7),o[1],0,0,0), C1,12); \
    }while(0)
  int t=1;
  #undef CMASK
  #define CMASK(P0,P1,t) do{}while(0)
  for(;t+5<NT;t+=2){
    STEP(pB0,pB1,pA0,pA1,t,true,true,true);     WAIT_BAR(2); RESC(); ROT();
    STEP(pA0,pA1,pB0,pB1,t+1,true,true,true);   WAIT_BAR(2); RESC(); ROT();
  }
  #undef CMASK
  #define CMASK(P0,P1,t) do{int jb_=(t)-(NT-4); if(jb_>=0)cmask(P0,P1,jb_,qrel,hi);}while(0)
  #define ENDW(tt) do{ if((tt)+3<NT){WAIT_BAR(2);} else if((tt)+2<NT){WAIT_BAR(1);} else {WAIT_BAR(0);} }while(0)
  for(;t+1<NT;t+=2){
    STEP(pB0,pB1,pA0,pA1,t,(t+3<NT),(t+1<NT),(t+1<NT));       ENDW(t);   RESC(); ROT();
    STEP(pA0,pA1,pB0,pB1,t+1,(t+4<NT),(t+2<NT),(t+2<NT));     ENDW(t+1); RESC(); ROT();
  }
  STEP(pB0,pB1,pA0,pA1,NT-1,false,false,false); RESC();
  { float sacc=pB0[0]+pB0[1]; _Pragma("unroll") for(int r=2;r<16;++r)sacc+=pB0[r]; _Pragma("unroll") for(int r=0;r<16;++r)sacc+=pB1[r]; l_reg+=sacc;
    pw0=(u32x4){PKW(pB0,0),PKW(pB0,2),PKW(pB0,4),PKW(pB0,6)};pw1=(u32x4){PKW(pB0,8),PKW(pB0,10),PKW(pB0,12),PKW(pB0,14)};pw2=(u32x4){PKW(pB1,0),PKW(pB1,2),PKW(pB1,4),PKW(pB1,6)};pw3=(u32x4){PKW(pB1,8),PKW(pB1,10),PKW(pB1,12),PKW(pB1,14)};
    SBAR(); pv(o,vb0+sl_cur,PAF(0),PAF(1),PAF(2),PAF(3)); }
  #undef PKW
  #undef PAF
  #undef VFR
  #undef PIN
  #undef MX3
  #undef GAPA
  #undef GAPB
  #undef EX
  #undef VRD
  #undef KRD
  #undef STEP
  #undef ENDW
  {auto rr=__builtin_amdgcn_permlane32_swap(__float_as_uint(l_reg),__float_as_uint(l_reg),false,false);l_reg=__uint_as_float(rr[0])+__uint_as_float(rr[1]);}
  if(hi==0)wsf[32+r32]=l_reg;asm volatile("s_waitcnt lgkmcnt(0)":::"memory");
  float rli[16];
  #pragma unroll
  for(int r=0;r<16;++r)rli[r]=__builtin_amdgcn_rcpf(wsf[32+crow(r,hi)]);
  bf16*Ow=O+(rowbase+q0+wid*QBLK)*OPITCH+h*D;
  { bf16*stg=(bf16*)(shm+LDS_OST)+wid*2048;
    #pragma unroll
    for(int r=0;r<16;++r){const int orow=crow(r,hi);
      #pragma unroll
      for(int d0=0;d0<2;++d0)stg[orow*64+d0*32+r32]=__float2bfloat16(o[d0][r]*rli[r]);}
    asm volatile("s_waitcnt lgkmcnt(0)":::"memory");
    #pragma unroll
    for(int i=0;i<4;++i){const int row=i*8+(lane>>3),ch=lane&7; const u32x4 v=*(const u32x4*)(stg+row*64+ch*8); ATTN_STORE16(Ow+(long)row*OPITCH+ch*8,v);
      float q=0.f;
      #pragma unroll
      for(int e=0;e<4;++e){const float lo=__uint_as_float(v[e]<<16),hi_=__uint_as_float(v[e]&0xffff0000u);q+=lo*lo+hi_*hi_;}
      q+=__shfl_xor(q,1);q+=__shfl_xor(q,2);q+=__shfl_xor(q,4);
      if(ch==0)unsafeAtomicAdd(SS+(rowbase+q0+wid*QBLK+row),q);} }
  asm volatile("s_waitcnt lgkmcnt(0)\n\ts_barrier":::"memory");
  #undef DMA_K
  #undef DMA_V
  #undef CMASK
  #undef RESC
  #undef ROT
}
constexpr int ATTN_LDS_BYTES=LDS_BYTES;
constexpr int F2_OFF=90112, SCAN_OFF=F2_OFF+SEQ*4;
constexpr float LOG2E=1.4426950408889634f;
template<int THRL=8> __device__ __forceinline__ void attn_phase(char*lds,const bf16*Hq,const bf16*Hk,const bf16*Hv,bf16*O,const float*logf,int vcu,const float REF,float*SS){
  const int bh=vcu>>1,s=vcu&1,b=bh/NHEAD,h=bh%NHEAD; int tid_=threadIdx.x; asm volatile("":"+v"(tid_)); const int tid=tid_,lane=tid&63,wid=tid>>6;
  typedef __attribute__((address_space(3))) float lfloat;
  lfloat*F2=(lfloat*)(__attribute__((address_space(3))) char*)lds+F2_OFF/4; lfloat*SC=(lfloat*)(__attribute__((address_space(3))) char*)lds+SCAN_OFF/4;
  { const float*src=logf+((long)b*SEQ+tid*4)*NHEAD+h;
    float v0=src[0],v1=src[NHEAD],v2=src[2*NHEAD],v3=src[3*NHEAD];
    v1+=v0;v2+=v1;v3+=v2; float x=v3;
    #pragma unroll
    for(int d=1;d<64;d<<=1){const float t=__shfl_up(x,d);if(lane>=d)x+=t;}
    if(lane==63)SC[wid]=x;
    __syncthreads();
    float off=x-v3;
    #pragma unroll
    for(int w=0;w<NW;++w){const float pw=SC[w];if(w<wid)off+=pw;}
    F2[tid*4+0]=(off+v0)*LOG2E;F2[tid*4+1]=(off+v1)*LOG2E;F2[tid*4+2]=(off+v2)*LOG2E;F2[tid*4+3]=(off+v3)*LOG2E;
    __syncthreads(); }
  #pragma unroll 1
  for(int i=0;i<4;++i){ const int qb=(i>>1)*4+((i&1)?3-s:s); attn_unit<THRL>(b,h,qb,Hq,Hk,Hv,O,lds,F2,REF,SS); }
}
#undef SBAR
#undef WAIT_BAR
}
#include <hip/hip_cooperative_groups.h>
namespace cg = cooperative_groups;
constexpr int NWAVES = 8;
#ifndef REP_MASK
#define REP_MASK 0
#endif
constexpr int REP_MASK_ = REP_MASK;
#define REPS(k) (((REP_MASK_ >> (k)) & 1) + 1)
#define GSYNC() do { xcd_barrier(bar); if (REP_MASK_ & 256) xcd_barrier(bar); } while (0)
#define LSYNC() do { if (local_ok) xcc_barrier_local(bar); else xcd_barrier(bar); } while (0)
constexpr int BATCH = 16, SEQ = 2048, DM = 1024, M = BATCH * SEQ, FF = 2816, NGU = 2 * FF, NIN = 2048, INC = 2056, NH = 8;
constexpr size_t MiB = 1u << 20;
constexpr size_t WS_CTL = 0;
constexpr size_t WS_TAB = 512 * 1024;
constexpr size_t WS_STAT = 1 * MiB;
constexpr size_t WS_LOGF = 3 * MiB;
constexpr size_t WS_WGU1 = 4 * MiB, WS_WD1 = 15 * MiB, WS_WIN = 21 * MiB, WS_WOUT = 25 * MiB, WS_WGU2 = 27 * MiB, WS_WD2 = 38 * MiB, WS_WPOOL = 44 * MiB;
constexpr size_t WS_WF = 45 * MiB;
constexpr size_t WS_ASS = 46 * MiB;
constexpr size_t WS_XB = 48 * MiB;
constexpr size_t WS_ACT = 112 * MiB;
constexpr size_t WS_H = 352 * MiB;
constexpr size_t WS_Y = 288 * MiB;
constexpr size_t WS_END = 480 * MiB;
constexpr int RING_BYTES = 131072, LDS_BYTES = 147456;

#define GAS __attribute__((address_space(1)))
#define LAS __attribute__((address_space(3)))
typedef unsigned short u16;
typedef unsigned v4u __attribute__((ext_vector_type(4)));
typedef unsigned v2u __attribute__((ext_vector_type(2)));
typedef float f32x4 __attribute__((ext_vector_type(4)));
typedef short bf16x8 __attribute__((ext_vector_type(8)));
#define LDS_WAIT() asm volatile("s_waitcnt lgkmcnt(0)" ::: "memory")
__device__ __forceinline__ unsigned pk2(float lo, float hi) { return pg8::cvt_pk_bf16(lo, hi); }
__device__ __forceinline__ float wave_sum(float v) {
#pragma unroll
    for (int o = 1; o < 64; o <<= 1) v += __shfl_xor(v, o);
    return v;
}
__device__ __forceinline__ float bflo(unsigned w) { return __uint_as_float(w << 16); }
__device__ __forceinline__ float bfhi(unsigned w) { return __uint_as_float(w & 0xffff0000u); }

#define RLX_AGENT __ATOMIC_RELAXED, __HIP_MEMORY_SCOPE_AGENT
#define XB_TMO      128
#define XB_XCNT(j)  (256  + 64 * (j))
#define XB_XSUB(j)  (1280 + 64 * (j))
#define XB_XGEN(j)  (2304 + 64 * (j))
#define XB_TOP      3328
#define XB_TOPGEN   3392
#define XCD_BAR_WORDS 3456
#define XB_SPIN_CAP (1u << 18)

__device__ __forceinline__ unsigned xb_ld(unsigned* p)              { return __hip_atomic_load(p, __ATOMIC_RELAXED, __HIP_MEMORY_SCOPE_AGENT); }
__device__ __forceinline__ unsigned xb_add(unsigned* p, unsigned v) { return __hip_atomic_fetch_add(p, v, __ATOMIC_RELAXED, __HIP_MEMORY_SCOPE_AGENT); }
__device__ __forceinline__ unsigned xb_xcc_id() { return (unsigned)__builtin_amdgcn_s_getreg((3 << 11) | 20) & 0xFu; }
#define XB_SPIN(cond, bar) do { unsigned _sp = 0; while (cond) { __builtin_amdgcn_s_sleep(1); \
    if ((++_sp & 255u) == 0u) { if (xb_ld(&(bar)[XB_TMO])) break; if (_sp > XB_SPIN_CAP) { atomicAdd(&(bar)[XB_TMO], 1u); break; } } } } while (0)

struct XcdBarrier {
    unsigned* bar; unsigned x; unsigned rank;
    volatile LAS unsigned* st;
};

__device__ __forceinline__ XcdBarrier xcd_barrier_post(unsigned* bar, volatile LAS unsigned* st) {
    XcdBarrier b; b.bar = bar; b.x = xb_xcc_id(); b.st = st;
    b.rank = 0u; if (threadIdx.x == 0) b.rank = xb_add(&bar[XB_XCNT(b.x)], 1u);
    return b;
}
__device__ __forceinline__ void xcd_barrier_complete(unsigned* bar, unsigned x, unsigned& nloc, unsigned& nx) {
    const unsigned G = gridDim.x * gridDim.y * gridDim.z;
    unsigned sum, cnt, mine, sp = 0u;
    for (;;) {
        sum = 0u; cnt = 0u; mine = 0u;
#pragma unroll
        for (unsigned j = 0; j < 16; ++j) { const unsigned c = xb_ld(&bar[XB_XCNT(j)]); sum += c; cnt += (c > 0u) ? 1u : 0u; mine = (j == x) ? c : mine; }
        if (sum == G) break;
        __builtin_amdgcn_s_sleep(1);
        if ((++sp & 255u) == 0u) { if (xb_ld(&bar[XB_TMO])) break; if (sp > XB_SPIN_CAP) { atomicAdd(&bar[XB_TMO], 1u); break; } }
    }
    nloc = mine > 0u ? mine : 1u; nx = cnt > 0u ? cnt : 1u;
}

__device__ __forceinline__ void xcd_barrier(const XcdBarrier& b) {
    asm volatile("s_waitcnt vmcnt(0)" ::: "memory");
    __syncthreads();
    if (threadIdx.x == 0) {
        unsigned* bar = b.bar;
        __builtin_amdgcn_s_waitcnt(0);
        unsigned nloc = b.st[0], nx = b.st[1];
        if (nloc == 0u) { xcd_barrier_complete(bar, b.x, nloc, nx); b.st[0] = nloc; b.st[1] = nx; }
        const unsigned old = xb_add(&bar[XB_XSUB(b.x)], 1u);
        const unsigned gen = old / nloc;
        if (old + 1u == (gen + 1u) * nloc) {
            __builtin_amdgcn_fence(__ATOMIC_RELEASE, "agent");
            asm volatile("s_waitcnt vmcnt(0)" ::: "memory");
            const unsigned og = xb_add(&bar[XB_TOP], 1u);
            const unsigned tg = og / nx;
            if (og + 1u == (tg + 1u) * nx) xb_add(&bar[XB_TOPGEN], 1u);
            else XB_SPIN(xb_ld(&bar[XB_TOPGEN]) == tg, bar);
            __builtin_amdgcn_fence(__ATOMIC_ACQUIRE, "agent");
            xb_add(&bar[XB_XGEN(b.x)], 1u);
            asm volatile("s_waitcnt vmcnt(0)" ::: "memory");
        } else {
            XB_SPIN(xb_ld(&bar[XB_XGEN(b.x)]) == gen, bar);
            __builtin_amdgcn_fence(__ATOMIC_ACQUIRE, "agent");
            asm volatile("s_waitcnt vmcnt(0)" ::: "memory");
        }
    }
    __syncthreads();
}

#define XB_LSUB(j)  (4096 + 64 * (j))
#define XB_LGEN(j)  (5120 + 64 * (j))
__device__ __forceinline__ void xcc_barrier_local(const XcdBarrier& b) {
    asm volatile("s_waitcnt vmcnt(0)" ::: "memory");
    __syncthreads();
    if (threadIdx.x == 0) {
        unsigned* bar = b.bar; const unsigned nloc = b.st[0];
        const unsigned old = xb_add(&bar[XB_LSUB(b.x)], 1u), gen = old / nloc;
        if (old + 1u == (gen + 1u) * nloc) xb_add(&bar[XB_LGEN(b.x)], 1u);
        else XB_SPIN(xb_ld(&bar[XB_LGEN(b.x)]) == gen, bar);
        __builtin_amdgcn_fence(__ATOMIC_ACQUIRE, "agent");
        asm volatile("s_waitcnt vmcnt(0)" ::: "memory");
    }
    __syncthreads();
}

struct Args { const float* in[19]; float* out; unsigned char* ws; };

__device__ __forceinline__ void xpose_item(const float* W, int ldw, int k0, int n0, const float* gain, u16* WT, int K, int drow, LAS float* scr, int lane) {
#pragma unroll
    for (int i = 0; i < 32; ++i) { const int kk = 2 * i + (lane >> 5); float v = __builtin_nontemporal_load(W + (size_t)(k0 + kk) * ldw + n0 + (lane & 31));     if (gain) v *= gain[k0 + kk]; scr[kk * 33 + (lane & 31)] = v; }
    LDS_WAIT(); asm volatile("" ::: "memory");
    const int c = lane & 7;
#pragma unroll
    for (int j = 0; j < 4; ++j) { const int n = (lane >> 3) + 8 * j; const LAS float* s = scr + (8 * c) * 33 + n;
        v4u o; o.x = pk2(s[0 * 33], s[1 * 33]); o.y = pk2(s[2 * 33], s[3 * 33]); o.z = pk2(s[4 * 33], s[5 * 33]); o.w = pk2(s[6 * 33], s[7 * 33]);
        *(v4u*)(WT + (size_t)(drow + n) * K + k0 + 8 * c) = o; }
    LDS_WAIT(); asm volatile("" ::: "memory");
}
template <int MODE> __device__ __forceinline__ void xpose_mat(const float* W, int ldw, int K, int N, const float* gain, u16* WT, LAS float* scr, int lane, int r) {
    const int nblk = N / 32, kb = r / nblk, nb = r % nblk, k0 = 64 * kb, n0 = 32 * nb; int drow = n0;
    if (MODE == 1 || MODE == 2) drow = 256 * (n0 / 128) + (n0 % 128) + (MODE == 2 ? 128 : 0);
    if (MODE == 3 && n0 < 512) return;
    if (MODE == 3 && n0 >= 512 && n0 < 1536) drow = 256 * (n0 / 256) + 128 * ((n0 % 64) / 32) + 32 * ((n0 % 256) / 64);
    xpose_item(W, ldw, k0, n0, gain, WT, K, drow, scr, lane);
}

template <int MODE> __device__ __forceinline__ void xpose8(const float* W, int ldw, int K, int ntiles, int ncol0, const float* gain, u16* WT, int ln, int r) {
    const int per = 8 * ntiles, kb = r / per, rem = r % per, nt = rem >> 3, k0 = kb * 64 + (rem & 7) * 8, n = ncol0 + nt * 256 + 4 * ln;
    f32x4 v[8];
#pragma unroll
    for (int i = 0; i < 8; ++i) v[i] = __builtin_nontemporal_load((const f32x4*)(W + (size_t)(k0 + i) * ldw + n));
    if (gain) {
#pragma unroll
        for (int i = 0; i < 8; ++i) v[i] = v[i] * gain[k0 + i]; }
    int drow = n;
    if (MODE == 1 || MODE == 2) drow = 256 * (n / 128) + (n % 128) + (MODE == 2 ? 128 : 0);
    if (MODE == 3 && n >= 512 && n < 1536) drow = 256 * (n / 256) + 128 * ((n % 64) / 32) + 32 * ((n % 256) / 64) + (n % 32);
#pragma unroll
    for (int j = 0; j < 4; ++j) { v4u o; o.x = pk2(v[0][j], v[1][j]); o.y = pk2(v[2][j], v[3][j]); o.z = pk2(v[4][j], v[5][j]); o.w = pk2(v[6][j], v[7][j]);
        *(v4u*)(WT + (size_t)(drow + j) * K + k0) = o; }
}

__global__ void __launch_bounds__(NWAVES * 64, 2) hymba_fwd(Args args) {
    extern __shared__ __attribute__((aligned(16))) unsigned char lds[];
    cg::grid_group grid = cg::this_grid();
    LAS unsigned char* ldsl = (LAS unsigned char*)lds;
    const int tid = threadIdx.x, lane = tid & 63, wave = __builtin_amdgcn_readfirstlane(tid >> 6);
    const int G = gridDim.x; int bx = blockIdx.x; int vcu = (G % 8 == 0) ? (bx % 8) * (G / 8) + bx / 8 : bx;
    unsigned char* ws = args.ws;
    const float* x = args.in[0]; float* out = args.out;
    float* STAT = (float*)(ws + WS_STAT); float* STAT1 = STAT + M; float* STAT2 = STAT + 2 * M; float* LOGF = (float*)(ws + WS_LOGF); float* ASS = (float*)(ws + WS_ASS);
    u16* WGU1 = (u16*)(ws + WS_WGU1); u16* WD1 = (u16*)(ws + WS_WD1); u16* WIN = (u16*)(ws + WS_WIN); u16* WOUT = (u16*)(ws + WS_WOUT);
    u16* WGU2 = (u16*)(ws + WS_WGU2); u16* WD2 = (u16*)(ws + WS_WD2); u16* WF = (u16*)(ws + WS_WF);
    u16* XB = (u16*)(ws + WS_XB); u16* ACT = (u16*)(ws + WS_ACT); u16* H = (u16*)(ws + WS_H); u16* Y = (u16*)(ws + WS_Y);
    int gw = vcu * NWAVES + wave; const int NGW = G * NWAVES;

    if (tid < 64) ((LAS unsigned*)(ldsl + RING_BYTES))[tid] = 0u;
    if (ws == nullptr) grid.sync();
    XcdBarrier bar = xcd_barrier_post((unsigned*)(ws + WS_CTL) + 64, (volatile LAS unsigned*)(ldsl + RING_BYTES + 64));
    if (bx == 0 && tid == 0) { unsigned long long* tab = (unsigned long long*)(ws + WS_TAB);
        tab[0] = (unsigned long long)args.in[4]; tab[1] = (unsigned long long)args.in[6]; tab[2] = (unsigned long long)args.in[14]; tab[3] = (unsigned long long)args.in[16]; tab[4] = (unsigned long long)args.in[17]; tab[5] = (unsigned long long)args.in[18];
        tab[6] = (unsigned long long)args.in[5]; tab[7] = (unsigned long long)args.in[15];
        tab[8] = (unsigned long long)WD1; tab[9] = (unsigned long long)WIN; tab[10] = (unsigned long long)WOUT; tab[11] = (unsigned long long)WGU2; tab[12] = (unsigned long long)WD2; tab[13] = (unsigned long long)(args.in[13] - 512); }
    for (int rep_ = 0; rep_ < REPS(0); ++rep_) {
        LAS float* scr = (LAS float*)(ldsl + wave * 16384);
        constexpr int I_P = 4 * 16 * 4;
        const int gw0 = wave * G + vcu;
        for (int rep2_ = 0; rep2_ < REPS(9); ++rep2_) {
        for (int it = gw0; it < I_P + 16; it += NGW) {
            int r = it; int ln = lane; asm volatile("" : "+v"(ln));
            if (r < I_P) {
                const int g = r >> 6, k0 = ((r >> 2) & 15) * 64, d0 = (r & 3) * 32;
                const float* P = args.in[8] + (size_t)g * 16384 + d0;
#pragma unroll
                for (int i = 0; i < 16; ++i) { const int c = 8 * i + (ln >> 3), dd = (ln & 7) * 4; *(LAS f32x4*)(scr + c * 32 + dd) = *(const f32x4*)(P + (size_t)c * 128 + dd); }
                LDS_WAIT(); asm volatile("" ::: "memory");
                const float* wrow = args.in[6] + (size_t)(k0 + ln) * INC + 128 * g;
                float a[32];
#pragma unroll
                for (int d = 0; d < 32; ++d) a[d] = 0.f;
                f32x4 wv[32];
#pragma unroll
                for (int c4 = 0; c4 < 32; ++c4) wv[c4] = *(const f32x4*)(wrow + 4 * c4);
#pragma unroll
                for (int c4 = 0; c4 < 32; ++c4) { const f32x4 w4 = wv[c4];
#pragma unroll
                    for (int ci = 0; ci < 4; ++ci)
#pragma unroll
                        for (int d4 = 0; d4 < 8; ++d4) { const f32x4 p4 = *(const LAS f32x4*)(scr + (4 * c4 + ci) * 32 + 4 * d4);
                            a[4 * d4 + 0] += w4[ci] * p4[0]; a[4 * d4 + 1] += w4[ci] * p4[1]; a[4 * d4 + 2] += w4[ci] * p4[2]; a[4 * d4 + 3] += w4[ci] * p4[3]; } }
                const float gk = args.in[5][k0 + ln];
#pragma unroll
                for (int d = 0; d < 32; ++d) WIN[(size_t)(128 * g + d0 + d) * DM + k0 + ln] = (u16)(pk2(a[d] * gk, 0.f) & 0xffffu);
                LDS_WAIT(); asm volatile("" ::: "memory");
                continue; } r -= I_P;
            { const int k = 64 * r + ln; const float gk = args.in[5][k]; const f32x4 w0 = *(const f32x4*)(args.in[6] + (size_t)k * INC + NIN), w1 = *(const f32x4*)(args.in[6] + (size_t)k * INC + NIN + 4);
#pragma unroll
              for (int c = 0; c < 8; ++c) { WF[c * DM + k] = (u16)(pk2((c < 4 ? w0[c & 3] : w1[c & 3]) * gk, 0.f) & 0xffffu); WF[(8 + c) * DM + k] = 0; } }
        }
        constexpr int T_GU = (DM / 8) * (FF / 256);
        for (int it = gw; it < 2 * T_GU; it += NGW) {
            int r = it; int ln = lane; asm volatile("" : "+v"(ln));
            if (r < T_GU) { xpose8<1>(args.in[2], FF, DM, FF / 256, 0, args.in[1], WGU1, ln, r); continue; } r -= T_GU;
            xpose8<2>(args.in[3], FF, DM, FF / 256, 0, args.in[1], WGU1, ln, r);
        }
        }
        for (int rep2_ = 0; rep2_ < REPS(10); ++rep2_)
        for (int m0 = gw0 * 4; m0 < M; m0 += NGW * 4) {
            f32x4 v[4][4]; float sq[4];
#pragma unroll
            for (int r = 0; r < 4; ++r) { const f32x4* xr = (const f32x4*)(x + (size_t)(m0 + r) * DM) + lane;
#pragma unroll
                for (int j = 0; j < 4; ++j) v[r][j] = __builtin_nontemporal_load(xr + 64 * j); }
#pragma unroll
            for (int r = 0; r < 4; ++r) { float s_ = 0.f;
#pragma unroll
                for (int j = 0; j < 4; ++j) s_ += (v[r][j][0] * v[r][j][0] + v[r][j][1] * v[r][j][1]) + (v[r][j][2] * v[r][j][2] + v[r][j][3] * v[r][j][3]);
                sq[r] = wave_sum(s_); }
#pragma unroll
            for (int r = 0; r < 4; ++r) { v2u* o8 = (v2u*)(XB + (size_t)(m0 + r) * DM) + lane;
#pragma unroll
                for (int j = 0; j < 4; ++j) { v2u w; w.x = pk2(v[r][j][0], v[r][j][1]); w.y = pk2(v[r][j][2], v[r][j][3]); o8[64 * j] = w; } }
            if (lane < 4) { const float s01 = (lane & 1) ? sq[1] : sq[0], s23 = (lane & 1) ? sq[3] : sq[2]; STAT[m0 + lane] = (lane & 2) ? s23 : s01; STAT1[m0 + lane] = 0.f; STAT2[m0 + lane] = 0.f; ASS[m0 + lane] = 0.f; }
        }
    }
    GSYNC();
    bool local_ok;
    { volatile LAS unsigned* ctlw = (volatile LAS unsigned*)(ldsl + RING_BYTES);
      if (tid == 0) { unsigned ok = (G % 8 == 0 && bar.x < 8u) ? 1u : 0u;
#pragma unroll
          for (unsigned j = 0; j < 16; ++j) { const unsigned c = xb_ld(&bar.bar[XB_XCNT(j)]); if (c != (j < 8u ? (unsigned)(G / 8) : 0u)) ok = 0u; }
          ctlw[32] = ok; ctlw[33] = bar.rank; }
      __syncthreads();
      local_ok = ctlw[32] != 0u && (REP_MASK_ & 1024) == 0;
      if (local_ok) { const int rank = (int)ctlw[33], xcc = (int)bar.x; vcu = xcc * (G / 8) + rank; bx = rank * 8 + xcc; gw = vcu * NWAVES + wave; } }

    for (int rep_ = 0; rep_ < REPS(1); ++rep_)
    { pg8::Gemm g{XB, WGU1, M, NGU, DM}; pg8::StaticOrder S; S.init(M, NGU, G, bx); pg8::SideXpose sx{(const unsigned long long*)(ws + WS_TAB)};
      pg8::EpiGU<true> E{ACT, FF, STAT, sx};
      pg8::gemm_phase<pg8::EpiGU<true>, pg8::StaticOrder, true, true>(ldsl, g, S, E); }
    GSYNC();
    for (int rep_ = 0; rep_ < REPS(2); ++rep_)
    { pg8::Gemm g{ACT, WD1, M, DM, FF}; pg8::StaticOrder S; S.init(M, DM, G, bx); pg8::EpiRes<false> E{nullptr, XB, STAT1, 0.5f};
      pg8::gemm_phase<pg8::EpiRes<false>, pg8::StaticOrder, true, true>(ldsl, g, S, E); }
    LSYNC();
    for (int rep_ = 0; rep_ < REPS(3); ++rep_)
    { pg8::Gemm g{XB, WIN, M, NIN, DM}; pg8::StaticOrder S; S.init(M, NIN, G, bx); pg8::EpiIn E{H, STAT1, args.in[10], args.in[11], attn_body::C2};
      pg8::gemm_phase<pg8::EpiIn, pg8::StaticOrder, true, true>(ldsl, g, S, E); }
    for (int rep_ = 0; rep_ < REPS(5); ++rep_)
    {
        const int fr = lane & 15, fq = lane >> 4; const int row = vcu * 128 + wave * 16 + fr;
        const u16* ap = XB + (size_t)row * DM + 8 * fq; const u16* bp = WF + (size_t)fr * DM + 8 * fq;
        f32x4 c = (f32x4){0.f, 0.f, 0.f, 0.f};
#pragma unroll 16
        for (int ks = 0; ks < 32; ++ks) c = __builtin_amdgcn_mfma_f32_16x16x32_bf16(*(const bf16x8*)(bp + 32 * ks), *(const bf16x8*)(ap + 32 * ks), c, 0, 0, 0);
        if (fq < 2) { const float rs = pg8::row_rs(STAT1, row); const f32x4 bf = *(const f32x4*)(args.in[7] + 4 * fq); f32x4 o;
#pragma unroll
            for (int i = 0; i < 4; ++i) { const float z = c[i] * rs + bf[i]; o[i] = (z >= 0.f) ? -log1pf(expf(-z)) : (z - log1pf(expf(z))); }
            *(f32x4*)(LOGF + (size_t)row * NH + 4 * fq) = o; }
    }
    LSYNC();
    float aref;
    { float mq = fabsf(args.in[10][lane]), mk = fabsf(args.in[11][lane]);
#pragma unroll
      for (int o_ = 1; o_ < 64; o_ <<= 1) { mq = fmaxf(mq, __shfl_xor(mq, o_)); mk = fmaxf(mk, __shfl_xor(mk, o_)); }
      aref = attn_body::C2 * 64.0f * mq * mk * 1.02f; }
    for (int rep_ = 0; rep_ < REPS(4); ++rep_)
    attn_body::attn_phase<8>((char*)lds, (const attn_body::bf16*)(H + 512), (const attn_body::bf16*)(H + 1024), (const attn_body::bf16*)(H + 1536), (attn_body::bf16*)(Y + 512), LOGF, vcu, aref, ASS);
    for (int rep_ = 0; rep_ < REPS(6); ++rep_)
    {
        const float* pscale = args.in[9]; const float* pgain = args.in[12];
        const int ch = lane * 8, w = 2 << (lane >> 4);
        const f32x4 ps0 = *(const f32x4*)(pscale + ch), ps1 = *(const f32x4*)(pscale + ch + 4), pg0 = *(const f32x4*)(pgain + ch), pg1 = *(const f32x4*)(pgain + ch + 4);
        for (int unit = gw; unit < M / 16; unit += NGW) {
            const int r0 = unit * 16, t0 = r0 % SEQ; const u16* zp = H + (size_t)r0 * 2048 + ch;
            v4u zr[16], mr[16];
#pragma unroll
            for (int i = 0; i < 16; ++i) { zr[i] = *(const v4u*)(zp + (size_t)i * 2048); mr[i] = (t0 + i >= w) ? *(const v4u*)(zp + (size_t)(i - w) * 2048) : (v4u){0u, 0u, 0u, 0u}; }
            float S[8];
#pragma unroll
            for (int e = 0; e < 8; ++e) S[e] = 0.f;
#pragma unroll
            for (int j = 1; j <= 16; ++j) { if (j <= w && j <= t0) { const v4u c = *(const v4u*)(zp - (size_t)j * 2048);
                    S[0] += bflo(c.x); S[1] += bfhi(c.x); S[2] += bflo(c.y); S[3] += bfhi(c.y); S[4] += bflo(c.z); S[5] += bfhi(c.z); S[6] += bflo(c.w); S[7] += bfhi(c.w); } }
#pragma unroll
            for (int hh = 0; hh < 2; ++hh) {
                float y[8][8], q[8];
#pragma unroll
                for (int ii = 0; ii < 8; ++ii) { const int i = 8 * hh + ii, t = t0 + i; const v4u c = zr[i]; float z[8];
                    z[0] = bflo(c.x); z[1] = bfhi(c.x); z[2] = bflo(c.y); z[3] = bfhi(c.y); z[4] = bflo(c.z); z[5] = bfhi(c.z); z[6] = bflo(c.w); z[7] = bfhi(c.w);
                    { const v4u d = mr[i];
                        S[0] += z[0] - bflo(d.x); S[1] += z[1] - bfhi(d.x); S[2] += z[2] - bflo(d.y); S[3] += z[3] - bfhi(d.y); S[4] += z[4] - bflo(d.z); S[5] += z[5] - bfhi(d.z); S[6] += z[6] - bflo(d.w); S[7] += z[7] - bfhi(d.w); }
                    const float inv = __builtin_amdgcn_rcpf((float)((t + 1 < w) ? (t + 1) : w));
                    float qq = 0.f;
#pragma unroll
                    for (int e = 0; e < 8; ++e) { y[ii][e] = (S[e] * inv - z[e]) * (e < 4 ? ps0[e & 3] : ps1[e & 3]); qq += y[ii][e] * y[ii][e]; }
                    q[ii] = qq; }
#define RS_STEP(n, bit) _Pragma("unroll") for (int k = 0; k < (n) / 2; ++k) { const bool up = (lane & (bit)) != 0; const float send = up ? q[k] : q[k + (n) / 2]; const float keep = up ? q[k + (n) / 2] : q[k]; q[k] = keep + __shfl_xor(send, (bit)); }
                RS_STEP(8, 32) RS_STEP(4, 16) RS_STEP(2, 8)
#undef RS_STEP
                float tot = q[0]; tot += __shfl_xor(tot, 4); tot += __shfl_xor(tot, 2); tot += __shfl_xor(tot, 1);
                const float rsl = __builtin_amdgcn_rsqf(tot * (1.0f / 512.0f) + pg8::RMS_EPS);
#pragma unroll
                for (int ii = 0; ii < 8; ++ii) { const float rs = __int_as_float(__builtin_amdgcn_readlane(__float_as_int(rsl), ((ii & 4) ? 32 : 0) + ((ii & 2) ? 16 : 0) + ((ii & 1) ? 8 : 0)));
                    v4u o; o.x = pk2(y[ii][0] * rs * pg0[0], y[ii][1] * rs * pg0[1]); o.y = pk2(y[ii][2] * rs * pg0[2], y[ii][3] * rs * pg0[3]); o.z = pk2(y[ii][4] * rs * pg1[0], y[ii][5] * rs * pg1[1]); o.w = pk2(y[ii][6] * rs * pg1[2], y[ii][7] * rs * pg1[3]);
                    *(v4u*)(Y + (size_t)(r0 + 8 * hh + ii) * 1024 + ch) = o; }
            }
        }
    }
    LSYNC();
    { pg8::Gemm g{Y, WOUT, M, DM, DM}; pg8::StaticOrder S; S.init(M, DM, G, bx); pg8::EpiOut E{XB, STAT2, ASS};
      pg8::gemm_phase<pg8::EpiOut, pg8::StaticOrder, true, true>(ldsl, g, S, E); }
    LSYNC();
    { pg8::Gemm g{XB, WGU2, M, NGU, DM}; pg8::StaticOrder S; S.init(M, NGU, G, bx); pg8::EpiGU<false> E{ACT, FF, STAT2, pg8::SideXpose{}};
      pg8::gemm_phase<pg8::EpiGU<false>, pg8::StaticOrder, true, true>(ldsl, g, S, E); }
    LSYNC();
    for (int rep_ = 0; rep_ < REPS(7); ++rep_)
    { pg8::Gemm g{ACT, WD2, M, DM, FF}; pg8::StaticOrder S; S.init(M, DM, G, bx); pg8::EpiRes<true> E{out, XB, nullptr, 0.5f};
      pg8::gemm_phase<pg8::EpiRes<true>, pg8::StaticOrder, true, true>(ldsl, g, S, E); }
}

extern "C" void kernel_launch(void* const* d_in, const int* in_sizes, int n_in, void* d_out, int out_size, void* d_ws, size_t ws_size, hipStream_t stream) {
    static int grid = 0;
    if (grid == 0) {
        if (n_in != 19 || in_sizes[0] != M * DM || out_size != M * DM || ws_size < WS_END) { fprintf(stderr, "kernel_launch: shape/workspace mismatch (n_in %d, in0 %d, out %d, ws %zu); nothing launched\n", n_in, n_in > 0 ? in_sizes[0] : -1, out_size, ws_size); grid = -1; return; }
        int dev = 0, cus = 0, per_cu = 0;
        if (hipGetDevice(&dev) != hipSuccess || hipDeviceGetAttribute(&cus, hipDeviceAttributeMultiprocessorCount, dev) != hipSuccess) { fprintf(stderr, "kernel_launch: device query failed\n"); grid = -1; return; }
        if (hipFuncSetAttribute((const void*)hymba_fwd, hipFuncAttributeMaxDynamicSharedMemorySize, LDS_BYTES) != hipSuccess) { fprintf(stderr, "kernel_launch: hipFuncSetAttribute failed\n"); grid = -1; return; }
        if (hipOccupancyMaxActiveBlocksPerMultiprocessor(&per_cu, (const void*)hymba_fwd, NWAVES * 64, LDS_BYTES) != hipSuccess || per_cu < 1) { fprintf(stderr, "kernel_launch: occupancy query reports %d blocks per CU\n", per_cu); per_cu = 1; }
        (void)hipGetLastError();
        grid = cus;
    }
    if (grid < 0) return;
    if (hipMemsetAsync((char*)d_ws + WS_CTL, 0, 32768, stream) != hipSuccess) { fprintf(stderr, "kernel_launch: hipMemsetAsync of the barrier words failed; nothing launched\n"); return; }
    Args a{};
    for (int i = 0; i < 19; ++i) a.in[i] = (const float*)d_in[i];
    a.out = (float*)d_out; a.ws = (unsigned char*)d_ws;
    void* kargs[] = {&a};
    const hipError_t e = hipLaunchCooperativeKernel((const void*)hymba_fwd, dim3(grid), dim3(NWAVES * 64), kargs, LDS_BYTES, stream);
    if (e != hipSuccess) fprintf(stderr, "kernel_launch: cooperative launch failed: %s (grid %d)\n", hipGetErrorString(e), grid);
}
```

```cpp
#include <hip/hip_runtime.h>
#include <cstdio>
#include <cstdint>
namespace pg8 {
#define PG8_LAS __attribute__((address_space(3)))
typedef unsigned short bf16_t;
typedef short bf16x8 __attribute__((ext_vector_type(8)));
typedef float f32x4 __attribute__((ext_vector_type(4)));
typedef unsigned u32x4 __attribute__((ext_vector_type(4)));
constexpr int BM = 256, BK = 64, HALF = 128, HTB = HALF * BK * 2  , STAGE_BYTES = 8 * HTB, NXCD = 8, WGM = 4;

__host__ __device__ __forceinline__ int lds_byte(int r, int c) { const int st = (r >> 4) * 2 + (c >> 5), rr = r & 15, cc = c & 31, ob = rr * 64 + cc * 2; return st * 1024 + (ob ^ (((ob >> 9) & 1) << 5)); }
__host__ __device__ __forceinline__ void stage_rc(int b, int& R, int& C) { const int st = b / 1024, sb = b % 1024, swz = sb ^ (((sb >> 9) & 1) << 5); R = (st >> 1) * 16 + swz / 64; C = (st & 1) * 32 + (swz % 64) / 2; }
__host__ __device__ __forceinline__ int perm32(int rho) { const int n = rho >> 4, i = rho & 15; return 8 * (i >> 2) + 4 * n + (i & 3); }

struct Unit { int pm, pn; };
struct Gemm { const bf16_t* A; const bf16_t* Bt; int M, N, K; };

struct StaticOrder {
    int nM, nN, nwg, G, c;
    __host__ __device__ void init(int M, int N, int G_, int c_) { nM = M / BM; nN = N / BM; nwg = nM * nN; G = G_; c = c_; }
    __host__ __device__ bool next(int i, Unit& u) const {
        const long L = (long)i * G + c; if (L >= nwg) return false;
        int wgid = (int)L; { const int q = nwg / NXCD, r = nwg % NXCD, xcd = wgid % NXCD, off = wgid / NXCD; wgid = (xcd < r ? xcd * (q + 1) : r * (q + 1) + (xcd - r) * q) + off; }
        const int nig = WGM * nN, gid = wgid / nig, fm = gid * WGM, gsz = (nM - fm) < WGM ? (nM - fm) : WGM;
        u.pm = fm + ((wgid % nig) % gsz); u.pn = (wgid % nig) / gsz; return true;
    }
    __device__ __forceinline__ void a_ready(const Unit&) const {}
    __device__ __forceinline__ void done(const Unit&) const {}
};

typedef float f32x2cv __attribute__((ext_vector_type(2))); typedef __bf16 bf16x2cv __attribute__((ext_vector_type(2)));
__device__ __forceinline__ unsigned cvt_pk_bf16(float lo, float hi) { const f32x2cv v = {lo, hi}; return __builtin_bit_cast(unsigned, __builtin_convertvector(v, bf16x2cv)); }
typedef float f32x2 __attribute__((ext_vector_type(2)));
constexpr float RMS_EPS = 1e-6f;
__device__ __forceinline__ float rs_of(float sumsq) { return __builtin_amdgcn_rsqf(sumsq * (1.0f / 1024.0f) + RMS_EPS); }
__device__ __forceinline__ float row_rs(const float* stat, int row) { return rs_of(stat[row]); }
__device__ __forceinline__ void stat_preload(const float* stat, int pm, int wr, int lane, float (&pre)[2]) { pre[0] = stat[pm * BM + wr * 64 + lane]; pre[1] = stat[pm * BM + HALF + wr * 64 + lane]; }
__device__ __forceinline__ void tile_rs(const float (&pre)[2], int fr, float (&rs)[2][4]) {
    const float a0 = rs_of(pre[0]), a1 = rs_of(pre[1]);
#pragma unroll
    for (int m = 0; m < 4; ++m) { rs[0][m] = __shfl(a0, m * 16 + fr); rs[1][m] = __shfl(a1, m * 16 + fr); }
}
__device__ __forceinline__ float silu_mul(float g, float u) { return g * u * __builtin_amdgcn_rcpf(1.0f + __builtin_amdgcn_exp2f(g * -1.4426950408889634f)); }
struct SideXpose {
    const unsigned long long* tab;
    static constexpr int T_D = (2816 / 8) * 4, T_IN = (1024 / 8) * 6, T_O = (1024 / 8) * 4, T_GU = (1024 / 8) * 11, TOTAL = 2 * T_D + T_IN + T_O + 2 * T_GU;
    __device__ __forceinline__ void decode(int& r, const float*& W, int& ldw, int& K, int& ntiles, int& ncol0, const float*& gain, bf16_t*& WT, int& mode, int& kmin) const {
        int wi, gi, di; kmin = 0;
        if (r < T_D) { wi = 0; gi = -1; di = 8; ldw = 1024; K = 2816; ntiles = 4; ncol0 = 0; mode = 0; }
        else if ((r -= T_D) < T_IN) { wi = 1; gi = 6; di = 9; ldw = 2056; K = 1024; ntiles = 6; ncol0 = 512; mode = 3; }
        else if ((r -= T_IN) < T_O) { wi = 2; gi = 13; di = 10; ldw = 1024; K = 1024; ntiles = 4; ncol0 = 0; mode = 0; kmin = 512; }
        else if ((r -= T_O) < T_GU) { wi = 3; gi = 7; di = 11; ldw = 2816; K = 1024; ntiles = 11; ncol0 = 0; mode = 1; }
        else if ((r -= T_GU) < T_GU) { wi = 4; gi = 7; di = 11; ldw = 2816; K = 1024; ntiles = 11; ncol0 = 0; mode = 2; }
        else { r -= T_GU; wi = 5; gi = -1; di = 12; ldw = 1024; K = 2816; ntiles = 4; ncol0 = 0; mode = 0; }
        W = (const float*)tab[wi]; gain = gi >= 0 ? (const float*)tab[gi] : nullptr; WT = (bf16_t*)tab[di];
    }
};
template <bool SIDE> struct EpiGU {
    static constexpr bool PERM = true, AFTER_DRAIN = false, MIDK = false, PRELOAD = true;
    bf16_t* O; int ldo; const float* stat; SideXpose sx;
    __device__ __forceinline__ void preload(const Unit& u, int wr, int lane, float (&pre)[2]) const { stat_preload(stat, u.pm, wr, lane, pre); }
    __device__ __forceinline__ void operator()(const f32x4 (&acc)[2][2][4][2], const Unit& u, int wr, int wc, int fr, int fq, const float (&pre)[2]) const {
        const int row0 = u.pm * BM + wr * 64 + fr, col0 = u.pn * HALF + wc * 32 + 8 * fq;
        int sr = ((u.pn * 128 + u.pm) << 3) + wr * 4 + wc; const bool has = SIDE && sr < SideXpose::TOTAL;
        const float* sW = nullptr; const float* sgain = nullptr; bf16_t* sWT = nullptr; int sldw = 0, sK = 0, snt = 1, sn0 = 0, smode = 0, sk0 = 0, sn = 0, skmin = 0;
        f32x4 sv[8];
        if (has) { sx.decode(sr, sW, sldw, sK, snt, sn0, sgain, sWT, smode, skmin);
            const int per = 8 * snt, kb = sr / per, rem = sr % per; sk0 = kb * 64 + (rem & 7) * 8; sn = sn0 + (rem >> 3) * 256 + 4 * (fq * 16 + fr);
#pragma unroll
            for (int i = 0; i < 8; ++i) sv[i] = __builtin_nontemporal_load((const f32x4*)(sW + (size_t)(sk0 + i) * sldw + sn)); }
        float rsv[2][4]; tile_rs(pre, fr, rsv);
#pragma unroll
        for (int ai = 0; ai < 2; ++ai)
#pragma unroll
            for (int m = 0; m < 4; ++m) { const int row = row0 + ai * HALF + m * 16; const float rs = rsv[ai][m];
                const float c1 = rs * -1.4426950408889634f, k = __builtin_amdgcn_rcpf(rs * rs);
                const f32x4 t0 = acc[ai][0][m][0] * c1, t1 = acc[ai][0][m][1] * c1, p0 = acc[ai][0][m][0] * acc[ai][1][m][0], p1 = acc[ai][0][m][1] * acc[ai][1][m][1];
                float o[8];
#pragma unroll
                for (int e = 0; e < 4; ++e) { o[e] = p0[e] * __builtin_amdgcn_rcpf(__builtin_fmaf(__builtin_amdgcn_exp2f(t0[e]), k, k)); o[4 + e] = p1[e] * __builtin_amdgcn_rcpf(__builtin_fmaf(__builtin_amdgcn_exp2f(t1[e]), k, k)); }
                u32x4 w; w.x = cvt_pk_bf16(o[0], o[1]); w.y = cvt_pk_bf16(o[2], o[3]); w.z = cvt_pk_bf16(o[4], o[5]); w.w = cvt_pk_bf16(o[6], o[7]);
                __builtin_nontemporal_store(w, (u32x4*)(O + (size_t)row * ldo + col0)); }
        if (has) {
            if (sgain && sk0 >= skmin) {
#pragma unroll
                for (int i = 0; i < 8; ++i) sv[i] = sv[i] * sgain[sk0 + i]; }
            int drow = sn;
            if (smode == 1 || smode == 2) drow = 256 * (sn / 128) + (sn % 128) + (smode == 2 ? 128 : 0);
            if (smode == 3 && sn < 1536) drow = 256 * (sn / 256) + 128 * ((sn % 64) / 32) + 32 * ((sn % 256) / 64) + (sn % 32);
#pragma unroll
            for (int j = 0; j < 4; ++j) { u32x4 o; o.x = cvt_pk_bf16(sv[0][j], sv[1][j]); o.y = cvt_pk_bf16(sv[2][j], sv[3][j]); o.z = cvt_pk_bf16(sv[4][j], sv[5][j]); o.w = cvt_pk_bf16(sv[6][j], sv[7][j]);
                *(u32x4*)(sWT + (size_t)(drow + j) * sK + sk0) = o; }
        }
    }
};
template <bool OUTF32> struct EpiRes {
    static constexpr bool PERM = true, AFTER_DRAIN = false, MIDK = false, PRELOAD = false;
    float* out; bf16_t* xb; float* stat; float alpha;
    __device__ __forceinline__ void operator()(const f32x4 (&acc)[2][2][4][2], const Unit& u, int wr, int wc, int fr, int fq, const float (&pre)[2]) const {
        const int row0 = u.pm * BM + wr * 64 + fr, col0 = u.pn * BM + wc * 32 + 8 * fq;
#pragma unroll
        for (int ai = 0; ai < 2; ++ai) {
        u32x4 rv[1][4][2];
#pragma unroll
            for (int m = 0; m < 4; ++m)
#pragma unroll
                for (int bj = 0; bj < 2; ++bj) rv[0][m][bj] = *(const u32x4*)(xb + (size_t)(row0 + ai * HALF + m * 16) * 1024 + col0 + bj * HALF);
            asm volatile("" ::: "memory");
#pragma unroll
            for (int m = 0; m < 4; ++m) { const int row = row0 + ai * HALF + m * 16; const size_t off = (size_t)row * 1024 + col0; float ss = 0.f;
#pragma unroll
                for (int bj = 0; bj < 2; ++bj) { const u32x4 r = rv[0][m][bj];
                    const f32x4 b0 = (f32x4){__uint_as_float(r.x << 16), __uint_as_float(r.x & 0xffff0000u), __uint_as_float(r.y << 16), __uint_as_float(r.y & 0xffff0000u)};
                    const f32x4 b1 = (f32x4){__uint_as_float(r.z << 16), __uint_as_float(r.z & 0xffff0000u), __uint_as_float(r.w << 16), __uint_as_float(r.w & 0xffff0000u)};
                    const f32x4 o0 = b0 + acc[ai][bj][m][0] * alpha, o1 = b1 + acc[ai][bj][m][1] * alpha;
                    if (OUTF32) { __builtin_nontemporal_store(o0, (f32x4*)(out + off + bj * HALF)); __builtin_nontemporal_store(o1, (f32x4*)(out + off + bj * HALF + 4)); }
                    else { u32x4 w; w.x = cvt_pk_bf16(o0[0], o0[1]); w.y = cvt_pk_bf16(o0[2], o0[3]); w.z = cvt_pk_bf16(o1[0], o1[1]); w.w = cvt_pk_bf16(o1[2], o1[3]);
                        *(u32x4*)(xb + off + bj * HALF) = w;
                        ss += ((o0[0] * o0[0] + o0[1] * o0[1]) + (o0[2] * o0[2] + o0[3] * o0[3])) + ((o1[0] * o1[0] + o1[1] * o1[1]) + (o1[2] * o1[2] + o1[3] * o1[3])); } }
                if (!OUTF32) { ss += __shfl_xor(ss, 16); ss += __shfl_xor(ss, 32); if (fq == 0) unsafeAtomicAdd(stat + row, ss); } }
        }
    }
};
struct EpiOut {
    static constexpr bool PERM = true, AFTER_DRAIN = false, MIDK = true, PRELOAD = true;
    bf16_t* xb; float* stat; const float* ss;
    __device__ __forceinline__ void preload(const Unit& u, int wr, int lane, float (&pre)[2]) const { stat_preload(ss, u.pm, wr, lane, pre); }
    __device__ __forceinline__ void scales(const float (&pre)[2], int lane, bool inv, float (&sc)[2][4]) const {
        const float v0 = pre[0] * (1.0f / 512.0f) + RMS_EPS, v1 = pre[1] * (1.0f / 512.0f) + RMS_EPS;
        const float a0 = inv ? __builtin_amdgcn_sqrtf(v0) : __builtin_amdgcn_rsqf(v0), a1 = inv ? __builtin_amdgcn_sqrtf(v1) : __builtin_amdgcn_rsqf(v1); const int fr = lane & 15;
#pragma unroll
        for (int m = 0; m < 4; ++m) { sc[0][m] = __shfl(a0, m * 16 + fr); sc[1][m] = __shfl(a1, m * 16 + fr); }
    }
    __device__ __forceinline__ void midk(f32x4 (&acc)[2][2][4][2], const float (&pre)[2], int lane) const {
        float sc[2][4]; scales(pre, lane, true, sc);
#pragma unroll
        for (int ai = 0; ai < 2; ++ai)
#pragma unroll
            for (int bj = 0; bj < 2; ++bj)
#pragma unroll
                for (int m = 0; m < 4; ++m)
#pragma unroll
                    for (int n = 0; n < 2; ++n) acc[ai][bj][m][n] = acc[ai][bj][m][n] * sc[ai][m];
    }
    __device__ __forceinline__ void operator()(const f32x4 (&acc)[2][2][4][2], const Unit& u, int wr, int wc, int fr, int fq, const float (&pre)[2]) const {
        const int row0 = u.pm * BM + wr * 64 + fr, col0 = u.pn * BM + wc * 32 + 8 * fq;
        float sc[2][4]; scales(pre, fq * 16 + fr, false, sc);
#pragma unroll
        for (int ai = 0; ai < 2; ++ai) {
        u32x4 rv[4][2];
#pragma unroll
            for (int m = 0; m < 4; ++m)
#pragma unroll
                for (int bj = 0; bj < 2; ++bj) rv[m][bj] = *(const u32x4*)(xb + (size_t)(row0 + ai * HALF + m * 16) * 1024 + col0 + bj * HALF);
            asm volatile("" ::: "memory");
#pragma unroll
            for (int m = 0; m < 4; ++m) { const int row = row0 + ai * HALF + m * 16; const size_t off = (size_t)row * 1024 + col0; float ss_ = 0.f; const float s = sc[ai][m];
#pragma unroll
                for (int bj = 0; bj < 2; ++bj) { const u32x4 r = rv[m][bj];
                    const f32x4 b0 = (f32x4){__uint_as_float(r.x << 16), __uint_as_float(r.x & 0xffff0000u), __uint_as_float(r.y << 16), __uint_as_float(r.y & 0xffff0000u)};
                    const f32x4 b1 = (f32x4){__uint_as_float(r.z << 16), __uint_as_float(r.z & 0xffff0000u), __uint_as_float(r.w << 16), __uint_as_float(r.w & 0xffff0000u)};
                    const f32x4 o0 = b0 + acc[ai][bj][m][0] * s, o1 = b1 + acc[ai][bj][m][1] * s;
                    u32x4 w; w.x = cvt_pk_bf16(o0[0], o0[1]); w.y = cvt_pk_bf16(o0[2], o0[3]); w.z = cvt_pk_bf16(o1[0], o1[1]); w.w = cvt_pk_bf16(o1[2], o1[3]);
                    *(u32x4*)(xb + off + bj * HALF) = w;
                    ss_ += ((o0[0] * o0[0] + o0[1] * o0[1]) + (o0[2] * o0[2] + o0[3] * o0[3])) + ((o1[0] * o1[0] + o1[1] * o1[1]) + (o1[2] * o1[2] + o1[3] * o1[3])); }
                ss_ += __shfl_xor(ss_, 16); ss_ += __shfl_xor(ss_, 32); if (fq == 0) unsafeAtomicAdd(stat + row, ss_); }
        }
    }
};
struct EpiIn {
    static constexpr bool PERM = true, AFTER_DRAIN = false, MIDK = false, PRELOAD = true;
    bf16_t* H; const float* stat; const float* qg; const float* kg; float qscale;
    __device__ __forceinline__ void preload(const Unit& u, int wr, int lane, float (&pre)[2]) const { stat_preload(stat, u.pm, wr, lane, pre); }
    __device__ __forceinline__ void operator()(const f32x4 (&acc)[2][2][4][2], const Unit& u, int wr, int wc, int fr, int fq, const float (&pre)[2]) const {
        const int row0 = u.pm * BM + wr * 64 + fr; const int pn = u.pn; const bool hp = (pn >= 2 && pn < 6);
        float rsv[2][4]; tile_rs(pre, fr, rsv);
        if (!hp) { const int col0 = pn * BM + wc * 32 + 8 * fq;
#pragma unroll
            for (int ai = 0; ai < 2; ++ai)
#pragma unroll
                for (int m = 0; m < 4; ++m) { const int row = row0 + ai * HALF + m * 16; const float rs = rsv[ai][m];
#pragma unroll
                    for (int bj = 0; bj < 2; ++bj) { const f32x4 v0 = acc[ai][bj][m][0] * rs, v1 = acc[ai][bj][m][1] * rs;
                        u32x4 w; w.x = cvt_pk_bf16(v0[0], v0[1]); w.y = cvt_pk_bf16(v0[2], v0[3]); w.z = cvt_pk_bf16(v1[0], v1[1]); w.w = cvt_pk_bf16(v1[2], v1[3]);
                        *(u32x4*)(H + (size_t)row * 2048 + col0 + bj * HALF) = w; } }
        } else { const float* g = (pn < 4) ? qg : kg; const float sc = (pn < 4) ? qscale : 1.0f; const int col0 = pn * BM + wc * 64 + 8 * fq;
            f32x4 gv[2][2];
#pragma unroll
            for (int bj = 0; bj < 2; ++bj)
#pragma unroll
                for (int n = 0; n < 2; ++n) gv[bj][n] = *(const f32x4*)(g + 32 * bj + 8 * fq + 4 * n) * sc;
#pragma unroll
            for (int ai = 0; ai < 2; ++ai)
#pragma unroll
                for (int m = 0; m < 4; ++m) { const int row = row0 + ai * HALF + m * 16; const float rs = rsv[ai][m];
                    float ss = 0.f;
#pragma unroll
                    for (int bj = 0; bj < 2; ++bj)
#pragma unroll
                        for (int n = 0; n < 2; ++n) { const f32x4 x = acc[ai][bj][m][n]; ss += (x[0] * x[0] + x[1] * x[1]) + (x[2] * x[2] + x[3] * x[3]); }
                    ss += __shfl_xor(ss, 16); ss += __shfl_xor(ss, 32);
                    const float r = __builtin_amdgcn_rsqf(ss * (1.0f / 64.0f) + RMS_EPS * __builtin_amdgcn_rcpf(rs * rs));
#pragma unroll
                    for (int bj = 0; bj < 2; ++bj) { const f32x4 v0 = acc[ai][bj][m][0] * (gv[bj][0] * r), v1 = acc[ai][bj][m][1] * (gv[bj][1] * r);
                        u32x4 w; w.x = cvt_pk_bf16(v0[0], v0[1]); w.y = cvt_pk_bf16(v0[2], v0[3]); w.z = cvt_pk_bf16(v1[0], v1[1]); w.w = cvt_pk_bf16(v1[2], v1[3]);
                        *(u32x4*)(H + (size_t)row * 2048 + col0 + bj * 32) = w; } }
        }
    }
};
template <class Epi, class Sched, bool ALIGN_EPI = false, bool SP2 = false>
__device__ __forceinline__ void gemm_phase(PG8_LAS unsigned char* lds, const Gemm g, const Sched& S, const Epi& E) {
    int tid_ = threadIdx.x; asm volatile("" : "+v"(tid_));
    const int tid = tid_, wid = __builtin_amdgcn_readfirstlane(tid >> 6), lane = tid & 63, wr = wid >> 2, wc = wid & 3, fr = lane & 15, fq = lane >> 4;
    const int K = g.K, nt = K / BK;
    unsigned voffA[2], voffB[2];
#pragma unroll
    for (int i = 0; i < 2; ++i) { int R, C; stage_rc(tid * 16 + i * 8192, R, C); const int Rb = Epi::PERM ? ((R & ~31) + perm32(R & 31)) : R;
        voffA[i] = (unsigned)(R * K + C) * 2u; voffB[i] = (unsigned)(Rb * K + C) * 2u; }
    const size_t kstep = (size_t)(BK * 2);
    const size_t hstep = (size_t)HALF * K * 2;
    const size_t tstep = 2 * hstep;
    const unsigned ldsw = (unsigned)wid * 1024u;
    const int aoff = lds_byte(wr * 64 + fr, fq * 8), boff = lds_byte(wc * 32 + fr, fq * 8);
#define PG8_SA(b, h) (((b) * 2 + (h)) * HTB)
#define PG8_SB(b, h) ((4 + (b) * 2 + (h)) * HTB)
#define PG8_STAGE(bufoff, gbase, voff) do { _Pragma("unroll") for (int _i = 0; _i < 2; ++_i) \
        __builtin_amdgcn_global_load_lds((const unsigned*)((const char*)(gbase) + (voff)[_i]), (PG8_LAS unsigned*)(lds + (bufoff) + ldsw + _i * 8192), 16, 0, 0); } while (0)
#define PG8_LDA(dst, b, h) do { _Pragma("unroll") for (int m = 0; m < 4; ++m) _Pragma("unroll") for (int k = 0; k < 2; ++k) dst[m][k] = *(const PG8_LAS bf16x8*)(lds + PG8_SA(b, h) + aoff + m * 2048 + k * 1024); } while (0)
#define PG8_LDB(dst, b, h) do { _Pragma("unroll") for (int n = 0; n < 2; ++n) _Pragma("unroll") for (int k = 0; k < 2; ++k) dst[n][k] = *(const PG8_LAS bf16x8*)(lds + PG8_SB(b, h) + boff + n * 2048 + k * 1024); } while (0)
#define PG8_MMA(ai, bj, At, Bt) do { __builtin_amdgcn_s_setprio(1); _Pragma("unroll") for (int m = 0; m < 4; ++m) _Pragma("unroll") for (int n = 0; n < 2; ++n) _Pragma("unroll") for (int k = 0; k < 2; ++k) \
        acc[ai][bj][m][n] = __builtin_amdgcn_mfma_f32_16x16x32_bf16(Bt[n][k], At[m][k], acc[ai][bj][m][n], 0, 0, 0); __builtin_amdgcn_s_setprio(0); } while (0)
#define PG8_WAIT_V(n) asm volatile("s_waitcnt vmcnt(" #n ")" ::: "memory")
#define PG8_WAIT_L(n) asm volatile("s_waitcnt lgkmcnt(" #n ")" ::: "memory")
#define PG8_BAR __builtin_amdgcn_s_barrier()
#define PG8_SCHED __builtin_amdgcn_sched_barrier(0)
    Unit cur, nxt; int ui = 0;
    if (!S.next(0, cur)) return;
    f32x4 acc[2][2][4][2];
#pragma unroll
    for (int a = 0; a < 2; ++a)
#pragma unroll
        for (int b = 0; b < 2; ++b)
#pragma unroll
            for (int m = 0; m < 4; ++m)
#pragma unroll
                for (int n = 0; n < 2; ++n) acc[a][b][m][n] = (f32x4){0.f, 0.f, 0.f, 0.f};
    bf16x8 At[4][2], B0[2][2], B1[2][2];
    const char* cA = (const char*)g.A + (size_t)cur.pm * tstep; const char* cB = (const char*)g.Bt + (size_t)cur.pn * tstep;
    float pre[2] = {0.f, 0.f};
    if constexpr (Epi::PRELOAD) E.preload(cur, wr, lane, pre);
    S.a_ready(cur);
    if constexpr (SP2) {
        PG8_STAGE(PG8_SB(0, 0), cB, voffB); PG8_STAGE(PG8_SB(0, 1), cB + hstep, voffB); PG8_STAGE(PG8_SA(0, 0), cA, voffA); PG8_STAGE(PG8_SA(0, 1), cA + hstep, voffA);
        if (wr == 1) PG8_BAR;
        PG8_WAIT_V(2); PG8_BAR;
        PG8_STAGE(PG8_SB(1, 0), cB + kstep, voffB); PG8_STAGE(PG8_SA(1, 0), cA + kstep, voffA); PG8_STAGE(PG8_SB(1, 1), cB + hstep + kstep, voffB);
        PG8_WAIT_V(6); PG8_BAR;
    } else {
        PG8_STAGE(PG8_SB(0, 0), cB, voffB); PG8_STAGE(PG8_SA(0, 0), cA, voffA); PG8_STAGE(PG8_SB(0, 1), cB + hstep, voffB); PG8_STAGE(PG8_SA(0, 1), cA + hstep, voffA);
        if (wr == 1) PG8_BAR;
        PG8_WAIT_V(4); PG8_BAR;
        PG8_STAGE(PG8_SB(1, 0), cB + kstep, voffB); PG8_STAGE(PG8_SA(1, 0), cA + kstep, voffA); PG8_STAGE(PG8_SB(1, 1), cB + hstep + kstep, voffB);
        PG8_WAIT_V(6); PG8_BAR;
    }
    for (;;) {
        const bool has_next = S.next(ui + 1, nxt);
        const char* nA = has_next ? (const char*)g.A + (size_t)nxt.pm * tstep : cA; const char* nB = has_next ? (const char*)g.Bt + (size_t)nxt.pn * tstep : cB;
        for (int t = 0; t < nt; t += 2) {
            if constexpr (Epi::MIDK) { if (t == nt / 2) E.midk(acc, pre, lane); }
            const bool last = (t == nt - 2);
            const char* a1 = cA + (size_t)(t + 1) * kstep;
            const char* a2 = last ? nA : cA + (size_t)(t + 2) * kstep; const char* b2 = last ? nB : cB + (size_t)(t + 2) * kstep;
            const char* a3 = a2 + kstep; const char* b3 = b2 + kstep;
            if (last && has_next) S.a_ready(nxt);
            if constexpr (SP2) {
            PG8_LDB(B0, 0, 0); PG8_LDB(B1, 0, 1); PG8_SCHED; PG8_LDA(At, 0, 0); PG8_STAGE(PG8_SA(1, 1), a1 + hstep, voffA);
            PG8_WAIT_V(8); PG8_WAIT_L(0); PG8_BAR; PG8_MMA(0, 0, At, B0); PG8_MMA(0, 1, At, B1); PG8_BAR; PG8_SCHED;
            PG8_LDA(At, 0, 1); PG8_STAGE(PG8_SB(0, 0), b2, voffB); PG8_STAGE(PG8_SB(0, 1), b2 + hstep, voffB); PG8_STAGE(PG8_SA(0, 0), a2, voffA);
            PG8_WAIT_V(8); PG8_WAIT_L(0); PG8_BAR; PG8_MMA(1, 0, At, B0); PG8_MMA(1, 1, At, B1); PG8_BAR; PG8_SCHED;
            PG8_LDB(B0, 1, 0); PG8_LDB(B1, 1, 1); PG8_SCHED; PG8_LDA(At, 1, 0); PG8_STAGE(PG8_SA(0, 1), a2 + hstep, voffA);
            PG8_WAIT_V(8); PG8_WAIT_L(0); PG8_BAR; PG8_MMA(0, 0, At, B0); PG8_MMA(0, 1, At, B1); PG8_BAR; PG8_SCHED;
            PG8_LDA(At, 1, 1); PG8_STAGE(PG8_SB(1, 0), b3, voffB); PG8_STAGE(PG8_SB(1, 1), b3 + hstep, voffB); PG8_STAGE(PG8_SA(1, 0), a3, voffA);
            PG8_WAIT_V(8); PG8_WAIT_L(0); PG8_BAR; PG8_MMA(1, 0, At, B0); PG8_MMA(1, 1, At, B1); PG8_BAR; PG8_SCHED;
            } else {
            PG8_LDB(B0, 0, 0); PG8_SCHED; PG8_LDA(At, 0, 0); PG8_STAGE(PG8_SA(1, 1), a1 + hstep, voffA);
            PG8_WAIT_L(8); PG8_BAR; PG8_WAIT_L(0); PG8_MMA(0, 0, At, B0); PG8_BAR; PG8_SCHED;
            PG8_LDB(B1, 0, 1); PG8_STAGE(PG8_SB(0, 0), b2, voffB);
            PG8_BAR; PG8_WAIT_L(0); PG8_MMA(0, 1, At, B1); PG8_BAR;
            PG8_LDA(At, 0, 1); PG8_STAGE(PG8_SA(0, 0), a2, voffA);
            PG8_BAR; PG8_WAIT_L(0); PG8_MMA(1, 0, At, B0); PG8_BAR; PG8_SCHED;
            PG8_STAGE(PG8_SB(0, 1), b2 + hstep, voffB);
            PG8_WAIT_V(6); PG8_BAR; PG8_MMA(1, 1, At, B1); PG8_BAR;
            PG8_LDB(B0, 1, 0); PG8_SCHED; PG8_LDA(At, 1, 0); PG8_STAGE(PG8_SA(0, 1), a2 + hstep, voffA);
            PG8_WAIT_L(8); PG8_BAR; PG8_WAIT_L(0); PG8_MMA(0, 0, At, B0); PG8_BAR; PG8_SCHED;
            PG8_LDB(B1, 1, 1); PG8_STAGE(PG8_SB(1, 0), b3, voffB);
            PG8_BAR; PG8_WAIT_L(0); PG8_MMA(0, 1, At, B1); PG8_BAR;
            PG8_LDA(At, 1, 1); PG8_STAGE(PG8_SA(1, 0), a3, voffA);
            PG8_BAR; PG8_WAIT_L(0); PG8_MMA(1, 0, At, B0); PG8_BAR; PG8_SCHED;
            PG8_STAGE(PG8_SB(1, 1), b3 + hstep, voffB);
            PG8_WAIT_V(6); PG8_BAR; PG8_MMA(1, 1, At, B1); PG8_BAR;
            }
        }
        if constexpr (ALIGN_EPI) { if (wr == 0) PG8_BAR; }
        if constexpr (!Epi::AFTER_DRAIN) { E(acc, cur, wr, wc, fr, fq, pre); S.done(cur); }
        if (!has_next) break;
#pragma unroll
        for (int a = 0; a < 2; ++a)
#pragma unroll
            for (int b = 0; b < 2; ++b)
#pragma unroll
                for (int m = 0; m < 4; ++m)
#pragma unroll
                    for (int n = 0; n < 2; ++n) acc[a][b][m][n] = (f32x4){0.f, 0.f, 0.f, 0.f};
        cur = nxt; cA = nA; cB = nB; ++ui;
        if constexpr (Epi::PRELOAD) E.preload(cur, wr, lane, pre);
        if constexpr (ALIGN_EPI) { if (wr == 1) PG8_BAR; }
    }
    PG8_WAIT_V(0);
    if constexpr (!ALIGN_EPI) { if (wr == 0) PG8_BAR; }
    PG8_BAR;
    if constexpr (Epi::AFTER_DRAIN) { E.fused(acc, cur, wr, wc, fr, fq, lds, wid, lane); S.done(cur); }
#undef PG8_SA
#undef PG8_SB
#undef PG8_STAGE
#undef PG8_LDA
#undef PG8_LDB
#undef PG8_MMA
#undef PG8_WAIT_V
#undef PG8_WAIT_L
#undef PG8_BAR
#undef PG8_SCHED
}
}

#ifndef PG8_SP2
#define PG8_SP2 true
#endif
#ifndef PG8_ALIGN
#define PG8_ALIGN true
#endif
#include <hip/hip_bf16.h>
#include <cmath>
namespace attn_body {
using bf16=__hip_bfloat16;
using bf16x8=__attribute__((ext_vector_type(8)))short;
using s16x4=__attribute__((ext_vector_type(4)))short;
using f32x16=__attribute__((ext_vector_type(16)))float;
using u32x4=__attribute__((ext_vector_type(4)))unsigned;
constexpr int BATCH=16,NHEAD=8,SEQ=2048,D=64,QPITCH=2048,OPITCH=1024;
constexpr int NW=8,QBLK=32,QB=QBLK*NW,KVBLK=64,NQB=SEQ/QB;
constexpr int ATTN_UNIT_ROWS=QB;
__device__ __forceinline__ int crow(int r,int hi){return (r&3)+8*(r>>2)+4*hi;}
#define SBAR() __builtin_amdgcn_sched_barrier(0)
__device__ __forceinline__ void cmask(f32x16&p0,f32x16&p1,int jb,int qrel,int hi){
  const float NEG=-INFINITY; int kb=64*jb+4*hi;
  #pragma unroll
  for(int r=0;r<16;++r){int kv=kb+(r&3)+8*(r>>2); if(kv>qrel)p0[r]=NEG; if(kv+32>qrel)p1[r]=NEG;}
}

constexpr int NSLOT=3, SLOTB=8192;
constexpr int LDS_K=0, LDS_V=NSLOT*SLOTB, LDS_WS=2*NSLOT*SLOTB, LDS_OST=LDS_WS+NW*64*4, LDS_BYTES=LDS_OST+NW*4096;
constexpr float C2=0.125f*1.4426950408889634f;
__device__ __forceinline__ void glds16(const void*gsrc,unsigned lds_dst){unsigned keep;
  asm volatile("s_mov_b32 %0, m0\n\ts_mov_b32 m0, %2\n\ts_nop 0\n\tglobal_load_lds_dwordx4 %1, off\n\ts_mov_b32 m0, %0":"=&s"(keep):"v"(gsrc),"s"(lds_dst):"memory");}
__device__ __forceinline__ float max3f(float a,float b,float c){float r;asm("v_max3_f32 %0, %1, %2, %3":"=v"(r):"v"(a),"v"(b),"v"(c));return r;}
__device__ __forceinline__ float max2f(float a,float b){float r;asm("v_max_f32_e32 %0, %1, %2":"=v"(r):"v"(a),"v"(b));return r;}
__device__ __forceinline__ float fadd_s(float a,float b){float r;asm("v_add_f32_e32 %0, %1, %2":"=v"(r):"v"(a),"v"(b));return r;}
__device__ __forceinline__ float fsub_s(float a,float b){float r;asm("v_sub_f32_e32 %0, %1, %2":"=v"(r):"v"(a),"v"(b));return r;}
typedef float f32x2_t __attribute__((ext_vector_type(2))); typedef __bf16 bf16x2_t __attribute__((ext_vector_type(2)));
__device__ __forceinline__ unsigned cvtpk_s(float lo,float hi){f32x2_t v={lo,hi};bf16x2_t b=__builtin_convertvector(v,bf16x2_t);return __builtin_bit_cast(unsigned,b);}
#define WAIT_BAR(N) asm volatile("s_waitcnt vmcnt(" #N ") lgkmcnt(0)\n\ts_barrier":::"memory")

__device__ __forceinline__ void qkt(f32x16&p0,f32x16&p1,const char*Kslot,const bf16x8*qr,int r32,int hi){
  const char*kb=Kslot+hi*1024+r32*16;
  #pragma unroll
  for(int d0=0;d0<4;++d0){
    const bf16x8 b0=*reinterpret_cast<const bf16x8*>(kb+d0*2048);
    const bf16x8 b1=*reinterpret_cast<const bf16x8*>(kb+d0*2048+512);
    p0=__builtin_amdgcn_mfma_f32_32x32x16_bf16(b0,qr[d0],p0,0,0,0);p1=__builtin_amdgcn_mfma_f32_32x32x16_bf16(b1,qr[d0],p1,0,0,0);}
}
typedef __attribute__((address_space(3))) const char* lds_cptr;
typedef short v4i16_t __attribute__((ext_vector_type(4)));
__device__ __forceinline__ void kload8(bf16x8*kf,lds_cptr kp){
  kf[0]=*(const __attribute__((address_space(3))) bf16x8*)(kp);      kf[1]=*(const __attribute__((address_space(3))) bf16x8*)(kp+512);
  kf[2]=*(const __attribute__((address_space(3))) bf16x8*)(kp+2048); kf[3]=*(const __attribute__((address_space(3))) bf16x8*)(kp+2560);
  kf[4]=*(const __attribute__((address_space(3))) bf16x8*)(kp+4096); kf[5]=*(const __attribute__((address_space(3))) bf16x8*)(kp+4608);
  kf[6]=*(const __attribute__((address_space(3))) bf16x8*)(kp+6144); kf[7]=*(const __attribute__((address_space(3))) bf16x8*)(kp+6656);
}
__device__ __forceinline__ void kload2(bf16x8*kf,lds_cptr kp,int j){ kf[2*j]=*(const __attribute__((address_space(3))) bf16x8*)(kp+j*2048); kf[2*j+1]=*(const __attribute__((address_space(3))) bf16x8*)(kp+j*2048+512); }
__device__ __forceinline__ s16x4 vtr(lds_cptr p){ return __builtin_bit_cast(s16x4,__builtin_amdgcn_ds_read_tr16_b64_v4i16((__attribute__((address_space(3))) v4i16_t*)p)); }
__device__ __forceinline__ float rowmax(const f32x16&p0,const f32x16&p1){
  float a=max3f(p0[0],p0[1],p1[0]),b=max3f(p0[2],p0[3],p1[1]);a=max3f(a,p1[2],p1[3]);
  #pragma unroll
  for(int r=4;r<16;r+=4){a=max3f(a,p0[r],p0[r+1]);b=max3f(b,p0[r+2],p0[r+3]);a=max3f(a,p1[r],p1[r+1]);b=max3f(b,p1[r+2],p1[r+3]);}
  const float m=max2f(a,b);
  auto rr=__builtin_amdgcn_permlane32_swap(__float_as_uint(m),__float_as_uint(m),false,false);
  return max2f(__uint_as_float(rr[0]),__uint_as_float(rr[1]));
}
__device__ __forceinline__ void pv(f32x16*o,int vb,bf16x8 pa0,bf16x8 pa1,bf16x8 pa2,bf16x8 pa3){
  #pragma unroll
  for(int d0=0;d0<2;++d0){s16x4 lo[4],hi[4];
    #pragma unroll
    for(int ks=0;ks<4;++ks){
      asm volatile("ds_read_b64_tr_b16 %0,%1 offset:%c2":"=&v"(lo[ks]):"v"(vb),"i"(d0*4096+ks*1024):"memory");
      asm volatile("ds_read_b64_tr_b16 %0,%1 offset:%c2":"=&v"(hi[ks]):"v"(vb),"i"(d0*4096+ks*1024+512):"memory");}
    asm volatile("s_waitcnt lgkmcnt(0)":::"memory");SBAR();
    #define PK(k) (bf16x8){lo[k][0],lo[k][1],lo[k][2],lo[k][3],hi[k][0],hi[k][1],hi[k][2],hi[k][3]}
    o[d0]=__builtin_amdgcn_mfma_f32_32x32x16_bf16(pa0,PK(0),o[d0],0,0,0);
    o[d0]=__builtin_amdgcn_mfma_f32_32x32x16_bf16(pa1,PK(1),o[d0],0,0,0);
    o[d0]=__builtin_amdgcn_mfma_f32_32x32x16_bf16(pa2,PK(2),o[d0],0,0,0);
    o[d0]=__builtin_amdgcn_mfma_f32_32x32x16_bf16(pa3,PK(3),o[d0],0,0,0);
    #undef PK
  }
}

#ifndef ATTN_STORE16
#define ATTN_STORE16(p,v) (*(u32x4*)(p)=(v))
#endif
template<int THRL> __device__ __forceinline__ void attn_unit(int b,int h,int qb,const bf16*Q,const bf16*__restrict__ K,const bf16*__restrict__ V,bf16*O,char*shm,const __attribute__((address_space(3))) float*F2,const float REF,float*SS){
  int tid_=threadIdx.x; asm volatile("":"+v"(tid_)); const int tid=tid_,lane=tid&63,r32=lane&31,hi=lane>>5; const int wid=__builtin_amdgcn_readfirstlane(tid>>6);
  const long rowbase=(long)b*SEQ; const int q0=qb*QB;
  const bf16*Qw=Q+(rowbase+q0+wid*QBLK)*QPITCH+h*D;
  const bf16*Kh=K+rowbase*QPITCH+h*D,*Vh=V+rowbase*QPITCH+h*D;
  const unsigned lds0=(unsigned)(uintptr_t)shm;
  float*wsf=(float*)(shm+LDS_WS)+wid*64;
  const bf16*ksrc=Kh+(long)lane*QPITCH+wid*8;
  const bf16*vsrc=Vh+(long)(16*(wid&3)+(lane>>2))*QPITCH+(wid>>2)*32+(lane&3)*8;
  const unsigned kdst=lds0+LDS_K+wid*1024, vdst=lds0+LDS_V+wid*1024;
  #define DMA_K(t,slot) glds16(ksrc+(long)(t)*KVBLK*QPITCH,(unsigned)__builtin_amdgcn_readfirstlane(kdst+(slot)))
  #define DMA_V(t,slot) glds16(vsrc+(long)(t)*KVBLK*QPITCH,(unsigned)__builtin_amdgcn_readfirstlane(vdst+(slot)))
  const int vb0=(int)(lds0+LDS_V)+((lane>>4)&1)*32+(lane&3)*8+(4*hi+((lane&15)>>2))*64;
  const char*Kbase=shm+LDS_K; bf16x8 kf[8];
  const lds_cptr shm3=(lds_cptr)shm; const lds_cptr kp0=shm3+LDS_K+hi*1024+r32*16; const lds_cptr vp0=shm3+LDS_V+((lane>>4)&1)*32+(lane&3)*8+(4*hi+((lane&15)>>2))*64;
  const int NT=(q0+QB)/KVBLK;
  DMA_K(0,0);DMA_V(0,0);DMA_K(1,SLOTB);
  bf16x8 qr[4];
  #pragma unroll
  for(int d0=0;d0<4;++d0)qr[d0]=*reinterpret_cast<const bf16x8*>(&Qw[(long)r32*QPITCH+d0*16+hi*8]);
  float l_reg=0.f;f32x16 o[2];o[0]=f32x16{};o[1]=f32x16{};
  const int qrel=wid*QBLK+r32;
  const float cq=F2[q0+qrel]-REF;
  typedef float f32x4b __attribute__((ext_vector_type(4)));
  #define CINIT(P0,P1,t) do{ const __attribute__((address_space(3))) float* fb_=F2+64*(t)+4*hi; const float nm_=cq; \
    _Pragma("unroll") for(int g_=0;g_<4;++g_){ const f32x4b a_=*(const __attribute__((address_space(3))) f32x4b*)(fb_+8*g_); const f32x4b b_=*(const __attribute__((address_space(3))) f32x4b*)(fb_+32+8*g_); \
      _Pragma("unroll") for(int i_=0;i_<4;++i_){ P0[4*g_+i_]=nm_-a_[i_]; P1[4*g_+i_]=nm_-b_[i_]; } SBAR(); } }while(0)
  #define CMASK(P0,P1,t) do{int jb_=(t)-(NT-4); if(jb_>=0)cmask(P0,P1,jb_,qrel,hi);}while(0)
  #define RESC() do{}while(0)
  f32x16 pA0,pA1,pB0,pB1;
  int sl_prev=0,sl_cur=0,sl_next=SLOTB;
  #define ROT() do{sl_prev=sl_cur;sl_cur=sl_next;sl_next=(sl_next==(NSLOT-1)*SLOTB)?0:sl_next+SLOTB;}while(0)
  DMA_K(2,2*SLOTB);
  WAIT_BAR(3);
  CINIT(pA0,pA1,0);qkt(pA0,pA1,Kbase,qr,r32,hi);asm volatile("s_nop 15\n\ts_nop 7":"+v"(pA0),"+v"(pA1));CMASK(pA0,pA1,0);
  _Pragma("unroll") for(int r=0;r<16;++r){pA0[r]=__builtin_amdgcn_exp2f(pA0[r]);pA1[r]=__builtin_amdgcn_exp2f(pA1[r]);}
  WAIT_BAR(0);
  DMA_K(3,0);DMA_V(1,SLOTB);
  ROT();
  kload8(kf,kp0+sl_cur);
  WAIT_BAR(2);
  s16x4 vlo[8],vhi[8]; u32x4 pw0,pw1,pw2,pw3;
  #define PKW(P,B) cvtpk_s(P[B],P[B+1])
  #define PAF(k) __builtin_bit_cast(bf16x8,pw##k)
  #define VFR(i) (bf16x8){vlo[i][0],vlo[i][1],vlo[i][2],vlo[i][3],vhi[i][0],vhi[i][1],vhi[i][2],vhi[i][3]}
  #define PIN(x) asm volatile("":"+v"(x))
  #define MX3(a,b,c) __builtin_fmaxf(__builtin_fmaxf((a),(b)),(c))
  #define GAPA(MF,A0,A1,A2,A3,W0,W1,PW) do{ MF; sacc+=A0; sacc+=A1; sacc+=A2; sacc+=A3; PIN(sacc); W0; W1; PIN(PW); SBAR(); }while(0)
  #define EX(v) __builtin_amdgcn_exp2f(v)
  #define GAPB(MF,X,B) do{ MF; X[B]=EX(X[B]); X[B+1]=EX(X[B+1]); X[B+2]=EX(X[B+2]); X[B+3]=EX(X[B+3]); PIN(X); SBAR(); }while(0)
  #define VRD(i) do{ vlo[i]=vtr(vp_+(((i)>>2)*4096+((i)&3)*1024)); vhi[i]=vtr(vp_+(((i)>>2)*4096+((i)&3)*1024+512)); }while(0)
  #define KRD(G,j) do{ if(G){ kload2(kf,kp0+sl_next,j); SBAR(); } }while(0)
  #define STEP(C0,C1,P0,P1,t,GK,GV,GL) do{ SBAR(); CINIT(C0,C1,t); SBAR(); \
    const lds_cptr vp_=vp0+sl_prev; \
    VRD(0); SBAR(); float sacc=(P0[0]+P0[1]); \
    GAPA(C0=__builtin_amdgcn_mfma_f32_32x32x16_bf16(kf[0],qr[0],C0,0,0,0), P0[2],P0[3],P0[4],P0[5],     pw0[0]=PKW(P0,0), pw0[1]=PKW(P0,2), pw0); \
    VRD(4); SBAR(); GAPA(C1=__builtin_amdgcn_mfma_f32_32x32x16_bf16(kf[1],qr[0],C1,0,0,0), P0[6],P0[7],P0[8],P0[9],     pw0[2]=PKW(P0,4), pw0[3]=PKW(P0,6), pw0); \
    VRD(1); SBAR(); GAPA(C0=__builtin_amdgcn_mfma_f32_32x32x16_bf16(kf[2],qr[1],C0,0,0,0),   P0[10],P0[11],P0[12],P0[13], pw1[0]=PKW(P0,8), pw1[1]=PKW(P0,10), pw1); \
    VRD(5); SBAR(); GAPA(C1=__builtin_amdgcn_mfma_f32_32x32x16_bf16(kf[3],qr[1],C1,0,0,0),   P0[14],P0[15],P1[0],P1[1],   pw1[2]=PKW(P0,12),pw1[3]=PKW(P0,14), pw1); \
    VRD(2); SBAR(); GAPA(C0=__builtin_amdgcn_mfma_f32_32x32x16_bf16(kf[4],qr[2],C0,0,0,0),   P1[2],P1[3],P1[4],P1[5],     pw2[0]=PKW(P1,0), pw2[1]=PKW(P1,2), pw2); \
    VRD(6); SBAR(); GAPA(C1=__builtin_amdgcn_mfma_f32_32x32x16_bf16(kf[5],qr[2],C1,0,0,0),   P1[6],P1[7],P1[8],P1[9],     pw2[2]=PKW(P1,4), pw2[3]=PKW(P1,6), pw2); \
    VRD(3); SBAR(); GAPA(C0=__builtin_amdgcn_mfma_f32_32x32x16_bf16(kf[6],qr[3],C0,0,0,0),   P1[10],P1[11],P1[12],P1[13], pw3[0]=PKW(P1,8), pw3[1]=PKW(P1,10), pw3); \
    VRD(7); SBAR(); GAPA(C1=__builtin_amdgcn_mfma_f32_32x32x16_bf16(kf[7],qr[3],C1,0,0,0),   P1[14],P1[15],0.f,0.f,       pw3[2]=PKW(P1,12),pw3[3]=PKW(P1,14), pw3); \
    l_reg+=sacc; \
    if(GK){DMA_K((t)+3,sl_cur);} if(GV){DMA_V((t)+1,sl_next);} \
    CMASK(C0,C1,t); \
    SBAR(); \
    GAPB(o[0]=__builtin_amdgcn_mfma_f32_32x32x16_bf16(PAF(0),VFR(0),o[0],0,0,0), C0,0); \
    GAPB(o[1]=__builtin_amdgcn_mfma_f32_32x32x16_bf16(PAF(0),VFR(4),o[1],0,0,0), C0,4); \
    KRD(GL,0); GAPB(o[0]=__builtin_amdgcn_mfma_f32_32x32x16_bf16(PAF(1),VFR(1),o[0],0,0,0), C0,8); \
    KRD(GL,1); GAPB(o[1]=__builtin_amdgcn_mfma_f32_32x32x16_bf16(PAF(1),VFR(5),o[1],0,0,0), C0,12); \
    KRD(GL,2); GAPB(o[0]=__builtin_amdgcn_mfma_f32_32x32x16_bf16(PAF(2),VFR(2),o[0],0,0,0), C1,0); \
    KRD(GL,3); GAPB(o[1]=__builtin_amdgcn_mfma_f32_32x32x16_bf16(PAF(2),VFR(6),o[1],0,0,0), C1,4); \
    GAPB(o[0]=__builtin_amdgcn_mfma_f32_32x32x16_bf16(PAF(3),VFR(3),o[0],0,0,0), C1,8); \
    GAPB(o[1]=__builtin_amdgcn_mfma_f32_32x32x16_bf16(PAF(3),VFR(7),o[1],0,0,0), C1,12); \
    }while(0)
  int t=1;
  #undef CMASK
  #define CMASK(P0,P1,t) do{}while(0)
  for(;t+5<NT;t+=2){
    STEP(pB0,pB1,pA0,pA1,t,true,true,true);     WAIT_BAR(2); RESC(); ROT();
    STEP(pA0,pA1,pB0,pB1,t+1,true,true,true);   WAIT_BAR(2); RESC(); ROT();
  }
  #undef CMASK
  #define CMASK(P0,P1,t) do{int jb_=(t)-(NT-4); if(jb_>=0)cmask(P0,P1,jb_,qrel,hi);}while(0)
  #define ENDW(tt) do{ if((tt)+3<NT){WAIT_BAR(2);} else if((tt)+2<NT){WAIT_BAR(1);} else {WAIT_BAR(0);} }while(0)
  for(;t+1<NT;t+=2){
    STEP(pB0,pB1,pA0,pA1,t,(t+3<NT),(t+1<NT),(t+1<NT));       ENDW(t);   RESC(); ROT();
    STEP(pA0,pA1,pB0,pB1,t+1,(t+4<NT),(t+2<NT),(t+2<NT));     ENDW(t+1); RESC(); ROT();
  }
  STEP(pB0,pB1,pA0,pA1,NT-1,false,false,false); RESC();
  { float sacc=pB0[0]+pB0[1]; _Pragma("unroll") for(int r=2;r<16;++r)sacc+=pB0[r]; _Pragma("unroll") for(int r=0;r<16;++r)sacc+=pB1[r]; l_reg+=sacc;
    pw0=(u32x4){PKW(pB0,0),PKW(pB0,2),PKW(pB0,4),PKW(pB0,6)};pw1=(u32x4){PKW(pB0,8),PKW(pB0,10),PKW(pB0,12),PKW(pB0,14)};pw2=(u32x4){PKW(pB1,0),PKW(pB1,2),PKW(pB1,4),PKW(pB1,6)};pw3=(u32x4){PKW(pB1,8),PKW(pB1,10),PKW(pB1,12),PKW(pB1,14)};
    SBAR(); pv(o,vb0+sl_cur,PAF(0),PAF(1),PAF(2),PAF(3)); }
  #undef PKW
  #undef PAF
  #undef VFR
  #undef PIN
  #undef MX3
  #undef GAPA
  #undef GAPB
  #undef EX
  #undef VRD
  #undef KRD
  #undef STEP
  #undef ENDW
  {auto rr=__builtin_amdgcn_permlane32_swap(__float_as_uint(l_reg),__float_as_uint(l_reg),false,false);l_reg=__uint_as_float(rr[0])+__uint_as_float(rr[1]);}
  if(hi==0)wsf[32+r32]=l_reg;asm volatile("s_waitcnt lgkmcnt(0)":::"memory");
  float rli[16];
  #pragma unroll
  for(int r=0;r<16;++r)rli[r]=__builtin_amdgcn_rcpf(wsf[32+crow(r,hi)]);
  bf16*Ow=O+(rowbase+q0+wid*QBLK)*OPITCH+h*D;
  { bf16*stg=(bf16*)(shm+LDS_OST)+wid*2048;
    #pragma unroll
    for(int r=0;r<16;++r){const int orow=crow(r,hi);
      #pragma unroll
      for(int d0=0;d0<2;++d0)stg[orow*64+d0*32+r32]=__float2bfloat16(o[d0][r]*rli[r]);}
    asm volatile("s_waitcnt lgkmcnt(0)":::"memory");
    #pragma unroll
    for(int i=0;i<4;++i){const int row=i*8+(lane>>3),ch=lane&7; const u32x4 v=*(const u32x4*)(stg+row*64+ch*8); ATTN_STORE16(Ow+(long)row*OPITCH+ch*8,v);
      float q=0.f;
      #pragma unroll
      for(int e=0;e<4;++e){const float lo=__uint_as_float(v[e]<<16),hi_=__uint_as_float(v[e]&0xffff0000u);q+=lo*lo+hi_*hi_;}
      q+=__shfl_xor(q,1);q+=__shfl_xor(q,2);q+=__shfl_xor(q,4);
      if(ch==0)unsafeAtomicAdd(SS+(rowbase+q0+wid*QBLK+row),q);} }
  asm volatile("s_waitcnt lgkmcnt(0)\n\ts_barrier":::"memory");
  #undef DMA_K
  #undef DMA_V
  #undef CMASK
  #undef RESC
  #undef ROT
}
constexpr int ATTN_LDS_BYTES=LDS_BYTES;
constexpr int F2_OFF=90112, SCAN_OFF=F2_OFF+SEQ*4;
constexpr float LOG2E=1.4426950408889634f;
template<int THRL=8> __device__ __forceinline__ void attn_phase(char*lds,const bf16*Hq,const bf16*Hk,const bf16*Hv,bf16*O,const float*logf,int vcu,const float REF,float*SS){
  const int bh=vcu>>1,s=vcu&1,b=bh/NHEAD,h=bh%NHEAD; int tid_=threadIdx.x; asm volatile("":"+v"(tid_)); const int tid=tid_,lane=tid&63,wid=tid>>6;
  typedef __attribute__((address_space(3))) float lfloat;
  lfloat*F2=(lfloat*)(__attribute__((address_space(3))) char*)lds+F2_OFF/4; lfloat*SC=(lfloat*)(__attribute__((address_space(3))) char*)lds+SCAN_OFF/4;
  { const float*src=logf+((long)b*SEQ+tid*4)*NHEAD+h;
    float v0=src[0],v1=src[NHEAD],v2=src[2*NHEAD],v3=src[3*NHEAD];
    v1+=v0;v2+=v1;v3+=v2; float x=v3;
    #pragma unroll
    for(int d=1;d<64;d<<=1){const float t=__shfl_up(x,d);if(lane>=d)x+=t;}
    if(lane==63)SC[wid]=x;
    __syncthreads();
    float off=x-v3;
    #pragma unroll
    for(int w=0;w<NW;++w){const float pw=SC[w];if(w<wid)off+=pw;}
    F2[tid*4+0]=(off+v0)*LOG2E;F2[tid*4+1]=(off+v1)*LOG2E;F2[tid*4+2]=(off+v2)*LOG2E;F2[tid*4+3]=(off+v3)*LOG2E;
    __syncthreads(); }
  #pragma unroll 1
  for(int i=0;i<4;++i){ const int qb=(i>>1)*4+((i&1)?3-s:s); attn_unit<THRL>(b,h,qb,Hq,Hk,Hv,O,lds,F2,REF,SS); }
}
#undef SBAR
#undef WAIT_BAR
}
#include <hip/hip_cooperative_groups.h>
namespace cg = cooperative_groups;
constexpr int NWAVES = 8;
#ifndef REP_MASK
#define REP_MASK 0
#endif
constexpr int REP_MASK_ = REP_MASK;
#define REPS(k) (((REP_MASK_ >> (k)) & 1) + 1)
#define GSYNC() do { xcd_barrier(bar); if (REP_MASK_ & 256) xcd_barrier(bar); } while (0)
#define LSYNC() do { if (local_ok) xcc_barrier_local(bar); else xcd_barrier(bar); } while (0)
constexpr int BATCH = 16, SEQ = 2048, DM = 1024, M = BATCH * SEQ, FF = 2816, NGU = 2 * FF, NIN = 2048, INC = 2056, NH = 8;
constexpr size_t MiB = 1u << 20;
constexpr size_t WS_CTL = 0;
constexpr size_t WS_TAB = 512 * 1024;
constexpr size_t WS_STAT = 1 * MiB;
constexpr size_t WS_LOGF = 3 * MiB;
constexpr size_t WS_WGU1 = 4 * MiB, WS_WD1 = 15 * MiB, WS_WIN = 21 * MiB, WS_WOUT = 25 * MiB, WS_WGU2 = 27 * MiB, WS_WD2 = 38 * MiB, WS_WPOOL = 44 * MiB;
constexpr size_t WS_WF = 45 * MiB;
constexpr size_t WS_ASS = 46 * MiB;
constexpr size_t WS_XB = 48 * MiB;
constexpr size_t WS_ACT = 112 * MiB;
constexpr size_t WS_H = 352 * MiB;
constexpr size_t WS_Y = 288 * MiB;
constexpr size_t WS_END = 480 * MiB;
constexpr int RING_BYTES = 131072, LDS_BYTES = 147456;

#define GAS __attribute__((address_space(1)))
#define LAS __attribute__((address_space(3)))
typedef unsigned short u16;
typedef unsigned v4u __attribute__((ext_vector_type(4)));
typedef unsigned v2u __attribute__((ext_vector_type(2)));
typedef float f32x4 __attribute__((ext_vector_type(4)));
typedef short bf16x8 __attribute__((ext_vector_type(8)));
#define LDS_WAIT() asm volatile("s_waitcnt lgkmcnt(0)" ::: "memory")
__device__ __forceinline__ unsigned pk2(float lo, float hi) { return pg8::cvt_pk_bf16(lo, hi); }
__device__ __forceinline__ float wave_sum(float v) {
#pragma unroll
    for (int o = 1; o < 64; o <<= 1) v += __shfl_xor(v, o);
    return v;
}
__device__ __forceinline__ float bflo(unsigned w) { return __uint_as_float(w << 16); }
__device__ __forceinline__ float bfhi(unsigned w) { return __uint_as_float(w & 0xffff0000u); }

#define RLX_AGENT __ATOMIC_RELAXED, __HIP_MEMORY_SCOPE_AGENT
#define XB_TMO      128
#define XB_XCNT(j)  (256  + 64 * (j))
#define XB_XSUB(j)  (1280 + 64 * (j))
#define XB_XGEN(j)  (2304 + 64 * (j))
#define XB_TOP      3328
#define XB_TOPGEN   3392
#define XCD_BAR_WORDS 3456
#define XB_SPIN_CAP (1u << 18)

__device__ __forceinline__ unsigned xb_ld(unsigned* p)              { return __hip_atomic_load(p, __ATOMIC_RELAXED, __HIP_MEMORY_SCOPE_AGENT); }
__device__ __forceinline__ unsigned xb_add(unsigned* p, unsigned v) { return __hip_atomic_fetch_add(p, v, __ATOMIC_RELAXED, __HIP_MEMORY_SCOPE_AGENT); }
__device__ __forceinline__ unsigned xb_xcc_id() { return (unsigned)__builtin_amdgcn_s_getreg((3 << 11) | 20) & 0xFu; }
#define XB_SPIN(cond, bar) do { unsigned _sp = 0; while (cond) { __builtin_amdgcn_s_sleep(1); \
    if ((++_sp & 255u) == 0u) { if (xb_ld(&(bar)[XB_TMO])) break; if (_sp > XB_SPIN_CAP) { atomicAdd(&(bar)[XB_TMO], 1u); break; } } } } while (0)

struct XcdBarrier {
    unsigned* bar; unsigned x; unsigned rank;
    volatile LAS unsigned* st;
};

__device__ __forceinline__ XcdBarrier xcd_barrier_post(unsigned* bar, volatile LAS unsigned* st) {
    XcdBarrier b; b.bar = bar; b.x = xb_xcc_id(); b.st = st;
    b.rank = 0u; if (threadIdx.x == 0) b.rank = xb_add(&bar[XB_XCNT(b.x)], 1u);
    return b;
}
__device__ __forceinline__ void xcd_barrier_complete(unsigned* bar, unsigned x, unsigned& nloc, unsigned& nx) {
    const unsigned G = gridDim.x * gridDim.y * gridDim.z;
    unsigned sum, cnt, mine, sp = 0u;
    for (;;) {
        sum = 0u; cnt = 0u; mine = 0u;
#pragma unroll
        for (unsigned j = 0; j < 16; ++j) { const unsigned c = xb_ld(&bar[XB_XCNT(j)]); sum += c; cnt += (c > 0u) ? 1u : 0u; mine = (j == x) ? c : mine; }
        if (sum == G) break;
        __builtin_amdgcn_s_sleep(1);
        if ((++sp & 255u) == 0u) { if (xb_ld(&bar[XB_TMO])) break; if (sp > XB_SPIN_CAP) { atomicAdd(&bar[XB_TMO], 1u); break; } }
    }
    nloc = mine > 0u ? mine : 1u; nx = cnt > 0u ? cnt : 1u;
}

__device__ __forceinline__ void xcd_barrier(const XcdBarrier& b) {
    asm volatile("s_waitcnt vmcnt(0)" ::: "memory");
    __syncthreads();
    if (threadIdx.x == 0) {
        unsigned* bar = b.bar;
        __builtin_amdgcn_s_waitcnt(0);
        unsigned nloc = b.st[0], nx = b.st[1];
        if (nloc == 0u) { xcd_barrier_complete(bar, b.x, nloc, nx); b.st[0] = nloc; b.st[1] = nx; }
        const unsigned old = xb_add(&bar[XB_XSUB(b.x)], 1u);
        const unsigned gen = old / nloc;
        if (old + 1u == (gen + 1u) * nloc) {
            __builtin_amdgcn_fence(__ATOMIC_RELEASE, "agent");
            asm volatile("s_waitcnt vmcnt(0)" ::: "memory");
            const unsigned og = xb_add(&bar[XB_TOP], 1u);
            const unsigned tg = og / nx;
            if (og + 1u == (tg + 1u) * nx) xb_add(&bar[XB_TOPGEN], 1u);
            else XB_SPIN(xb_ld(&bar[XB_TOPGEN]) == tg, bar);
            __builtin_amdgcn_fence(__ATOMIC_ACQUIRE, "agent");
            xb_add(&bar[XB_XGEN(b.x)], 1u);
            asm volatile("s_waitcnt vmcnt(0)" ::: "memory");
        } else {
            XB_SPIN(xb_ld(&bar[XB_XGEN(b.x)]) == gen, bar);
            __builtin_amdgcn_fence(__ATOMIC_ACQUIRE, "agent");
            asm volatile("s_waitcnt vmcnt(0)" ::: "memory");
        }
    }
    __syncthreads();
}

#define XB_LSUB(j)  (4096 + 64 * (j))
#define XB_LGEN(j)  (5120 + 64 * (j))
__device__ __forceinline__ void xcc_barrier_local(const XcdBarrier& b) {
    asm volatile("s_waitcnt vmcnt(0)" ::: "memory");
    __syncthreads();
    if (threadIdx.x == 0) {
        unsigned* bar = b.bar; const unsigned nloc = b.st[0];
        const unsigned old = xb_add(&bar[XB_LSUB(b.x)], 1u), gen = old / nloc;
        if (old + 1u == (gen + 1u) * nloc) xb_add(&bar[XB_LGEN(b.x)], 1u);
        else XB_SPIN(xb_ld(&bar[XB_LGEN(b.x)]) == gen, bar);
        __builtin_amdgcn_fence(__ATOMIC_ACQUIRE, "agent");
        asm volatile("s_waitcnt vmcnt(0)" ::: "memory");
    }
    __syncthreads();
}

struct Args { const float* in[19]; float* out; unsigned char* ws; };

__device__ __forceinline__ void xpose_item(const float* W, int ldw, int k0, int n0, const float* gain, u16* WT, int K, int drow, LAS float* scr, int lane) {
#pragma unroll
    for (int i = 0; i < 32; ++i) { const int kk = 2 * i + (lane >> 5); float v = __builtin_nontemporal_load(W + (size_t)(k0 + kk) * ldw + n0 + (lane & 31));     if (gain) v *= gain[k0 + kk]; scr[kk * 33 + (lane & 31)] = v; }
    LDS_WAIT(); asm volatile("" ::: "memory");
    const int c = lane & 7;
#pragma unroll
    for (int j = 0; j < 4; ++j) { const int n = (lane >> 3) + 8 * j; const LAS float* s = scr + (8 * c) * 33 + n;
        v4u o; o.x = pk2(s[0 * 33], s[1 * 33]); o.y = pk2(s[2 * 33], s[3 * 33]); o.z = pk2(s[4 * 33], s[5 * 33]); o.w = pk2(s[6 * 33], s[7 * 33]);
        *(v4u*)(WT + (size_t)(drow + n) * K + k0 + 8 * c) = o; }
    LDS_WAIT(); asm volatile("" ::: "memory");
}
template <int MODE> __device__ __forceinline__ void xpose_mat(const float* W, int ldw, int K, int N, const float* gain, u16* WT, LAS float* scr, int lane, int r) {
    const int nblk = N / 32, kb = r / nblk, nb = r % nblk, k0 = 64 * kb, n0 = 32 * nb; int drow = n0;
    if (MODE == 1 || MODE == 2) drow = 256 * (n0 / 128) + (n0 % 128) + (MODE == 2 ? 128 : 0);
    if (MODE == 3 && n0 < 512) return;
    if (MODE == 3 && n0 >= 512 && n0 < 1536) drow = 256 * (n0 / 256) + 128 * ((n0 % 64) / 32) + 32 * ((n0 % 256) / 64);
    xpose_item(W, ldw, k0, n0, gain, WT, K, drow, scr, lane);
}

template <int MODE> __device__ __forceinline__ void xpose8(const float* W, int ldw, int K, int ntiles, int ncol0, const float* gain, u16* WT, int ln, int r) {
    const int per = 8 * ntiles, kb = r / per, rem = r % per, nt = rem >> 3, k0 = kb * 64 + (rem & 7) * 8, n = ncol0 + nt * 256 + 4 * ln;
    f32x4 v[8];
#pragma unroll
    for (int i = 0; i < 8; ++i) v[i] = __builtin_nontemporal_load((const f32x4*)(W + (size_t)(k0 + i) * ldw + n));
    if (gain) {
#pragma unroll
        for (int i = 0; i < 8; ++i) v[i] = v[i] * gain[k0 + i]; }
    int drow = n;
    if (MODE == 1 || MODE == 2) drow = 256 * (n / 128) + (n % 128) + (MODE == 2 ? 128 : 0);
    if (MODE == 3 && n >= 512 && n < 1536) drow = 256 * (n / 256) + 128 * ((n % 64) / 32) + 32 * ((n % 256) / 64) + (n % 32);
#pragma unroll
    for (int j = 0; j < 4; ++j) { v4u o; o.x = pk2(v[0][j], v[1][j]); o.y = pk2(v[2][j], v[3][j]); o.z = pk2(v[4][j], v[5][j]); o.w = pk2(v[6][j], v[7][j]);
        *(v4u*)(WT + (size_t)(drow + j) * K + k0) = o; }
}

__global__ void __launch_bounds__(NWAVES * 64, 2) hymba_fwd(Args args) {
    extern __shared__ __attribute__((aligned(16))) unsigned char lds[];
    cg::grid_group grid = cg::this_grid();
    LAS unsigned char* ldsl = (LAS unsigned char*)lds;
    const int tid = threadIdx.x, lane = tid & 63, wave = __builtin_amdgcn_readfirstlane(tid >> 6);
    const int G = gridDim.x; int bx = blockIdx.x; int vcu = (G % 8 == 0) ? (bx % 8) * (G / 8) + bx / 8 : bx;
    unsigned char* ws = args.ws;
    const float* x = args.in[0]; float* out = args.out;
    float* STAT = (float*)(ws + WS_STAT); float* STAT1 = STAT + M; float* STAT2 = STAT + 2 * M; float* LOGF = (float*)(ws + WS_LOGF); float* ASS = (float*)(ws + WS_ASS);
    u16* WGU1 = (u16*)(ws + WS_WGU1); u16* WD1 = (u16*)(ws + WS_WD1); u16* WIN = (u16*)(ws + WS_WIN); u16* WOUT = (u16*)(ws + WS_WOUT);
    u16* WGU2 = (u16*)(ws + WS_WGU2); u16* WD2 = (u16*)(ws + WS_WD2); u16* WF = (u16*)(ws + WS_WF);
    u16* XB = (u16*)(ws + WS_XB); u16* ACT = (u16*)(ws + WS_ACT); u16* H = (u16*)(ws + WS_H); u16* Y = (u16*)(ws + WS_Y);
    int gw = vcu * NWAVES + wave; const int NGW = G * NWAVES;

    if (tid < 64) ((LAS unsigned*)(ldsl + RING_BYTES))[tid] = 0u;
    if (ws == nullptr) grid.sync();
    XcdBarrier bar = xcd_barrier_post((unsigned*)(ws + WS_CTL) + 64, (volatile LAS unsigned*)(ldsl + RING_BYTES + 64));
    if (bx == 0 && tid == 0) { unsigned long long* tab = (unsigned long long*)(ws + WS_TAB);
        tab[0] = (unsigned long long)args.in[4]; tab[1] = (unsigned long long)args.in[6]; tab[2] = (unsigned long long)args.in[14]; tab[3] = (unsigned long long)args.in[16]; tab[4] = (unsigned long long)args.in[17]; tab[5] = (unsigned long long)args.in[18];
        tab[6] = (unsigned long long)args.in[5]; tab[7] = (unsigned long long)args.in[15];
        tab[8] = (unsigned long long)WD1; tab[9] = (unsigned long long)WIN; tab[10] = (unsigned long long)WOUT; tab[11] = (unsigned long long)WGU2; tab[12] = (unsigned long long)WD2; tab[13] = (unsigned long long)(args.in[13] - 512); }
    for (int rep_ = 0; rep_ < REPS(0); ++rep_) {
        LAS float* scr = (LAS float*)(ldsl + wave * 16384);
        constexpr int I_P = 4 * 16 * 4;
        const int gw0 = wave * G + vcu;
        for (int rep2_ = 0; rep2_ < REPS(9); ++rep2_) {
        for (int it = gw0; it < I_P + 16; it += NGW) {
            int r = it; int ln = lane; asm volatile("" : "+v"(ln));
            if (r < I_P) {
                const int g = r >> 6, k0 = ((r >> 2) & 15) * 64, d0 = (r & 3) * 32;
                const float* P = args.in[8] + (size_t)g * 16384 + d0;
#pragma unroll
                for (int i = 0; i < 16; ++i) { const int c = 8 * i + (ln >> 3), dd = (ln & 7) * 4; *(LAS f32x4*)(scr + c * 32 + dd) = *(const f32x4*)(P + (size_t)c * 128 + dd); }
                LDS_WAIT(); asm volatile("" ::: "memory");
                const float* wrow = args.in[6] + (size_t)(k0 + ln) * INC + 128 * g;
                float a[32];
#pragma unroll
                for (int d = 0; d < 32; ++d) a[d] = 0.f;
                f32x4 wv[32];
#pragma unroll
                for (int c4 = 0; c4 < 32; ++c4) wv[c4] = *(const f32x4*)(wrow + 4 * c4);
#pragma unroll
                for (int c4 = 0; c4 < 32; ++c4) { const f32x4 w4 = wv[c4];
#pragma unroll
                    for (int ci = 0; ci < 4; ++ci)
#pragma unroll
                        for (int d4 = 0; d4 < 8; ++d4) { const f32x4 p4 = *(const LAS f32x4*)(scr + (4 * c4 + ci) * 32 + 4 * d4);
                            a[4 * d4 + 0] += w4[ci] * p4[0]; a[4 * d4 + 1] += w4[ci] * p4[1]; a[4 * d4 + 2] += w4[ci] * p4[2]; a[4 * d4 + 3] += w4[ci] * p4[3]; } }
                const float gk = args.in[5][k0 + ln];
#pragma unroll
                for (int d = 0; d < 32; ++d) WIN[(size_t)(128 * g + d0 + d) * DM + k0 + ln] = (u16)(pk2(a[d] * gk, 0.f) & 0xffffu);
                LDS_WAIT(); asm volatile("" ::: "memory");
                continue; } r -= I_P;
            { const int k = 64 * r + ln; const float gk = args.in[5][k]; const f32x4 w0 = *(const f32x4*)(args.in[6] + (size_t)k * INC + NIN), w1 = *(const f32x4*)(args.in[6] + (size_t)k * INC + NIN + 4);
#pragma unroll
              for (int c = 0; c < 8; ++c) { WF[c * DM + k] = (u16)(pk2((c < 4 ? w0[c & 3] : w1[c & 3]) * gk, 0.f) & 0xffffu); WF[(8 + c) * DM + k] = 0; } }
        }
        constexpr int T_GU = (DM / 8) * (FF / 256);
        for (int it = gw; it < 2 * T_GU; it += NGW) {
            int r = it; int ln = lane; asm volatile("" : "+v"(ln));
            if (r < T_GU) { xpose8<1>(args.in[2], FF, DM, FF / 256, 0, args.in[1], WGU1, ln, r); continue; } r -= T_GU;
            xpose8<2>(args.in[3], FF, DM, FF / 256, 0, args.in[1], WGU1, ln, r);
        }
        }
        for (int rep2_ = 0; rep2_ < REPS(10); ++rep2_)
        for (int m0 = gw0 * 4; m0 < M; m0 += NGW * 4) {
            f32x4 v[4][4]; float sq[4];
#pragma unroll
            for (int r = 0; r < 4; ++r) { const f32x4* xr = (const f32x4*)(x + (size_t)(m0 + r) * DM) + lane;
#pragma unroll
                for (int j = 0; j < 4; ++j) v[r][j] = __builtin_nontemporal_load(xr + 64 * j); }
#pragma unroll
            for (int r = 0; r < 4; ++r) { float s_ = 0.f;
#pragma unroll
                for (int j = 0; j < 4; ++j) s_ += (v[r][j][0] * v[r][j][0] + v[r][j][1] * v[r][j][1]) + (v[r][j][2] * v[r][j][2] + v[r][j][3] * v[r][j][3]);
                sq[r] = wave_sum(s_); }
#pragma unroll
            for (int r = 0; r < 4; ++r) { v2u* o8 = (v2u*)(XB + (size_t)(m0 + r) * DM) + lane;
#pragma unroll
                for (int j = 0; j < 4; ++j) { v2u w; w.x = pk2(v[r][j][0], v[r][j][1]); w.y = pk2(v[r][j][2], v[r][j][3]); o8[64 * j] = w; } }
            if (lane < 4) { const float s01 = (lane & 1) ? sq[1] : sq[0], s23 = (lane & 1) ? sq[3] : sq[2]; STAT[m0 + lane] = (lane & 2) ? s23 : s01; STAT1[m0 + lane] = 0.f; STAT2[m0 + lane] = 0.f; ASS[m0 + lane] = 0.f; }
        }
    }
    GSYNC();
    bool local_ok;
    { volatile LAS unsigned* ctlw = (volatile LAS unsigned*)(ldsl + RING_BYTES);
      if (tid == 0) { unsigned ok = (G % 8 == 0 && bar.x < 8u) ? 1u : 0u;
#pragma unroll
          for (unsigned j = 0; j < 16; ++j) { const unsigned c = xb_ld(&bar.bar[XB_XCNT(j)]); if (c != (j < 8u ? (unsigned)(G / 8) : 0u)) ok = 0u; }
          ctlw[32] = ok; ctlw[33] = bar.rank; }
      __syncthreads();
      local_ok = ctlw[32] != 0u && (REP_MASK_ & 1024) == 0;
      if (local_ok) { const int rank = (int)ctlw[33], xcc = (int)bar.x; vcu = xcc * (G / 8) + rank; bx = rank * 8 + xcc; gw = vcu * NWAVES + wave; } }

    for (int rep_ = 0; rep_ < REPS(1); ++rep_)
    { pg8::Gemm g{XB, WGU1, M, NGU, DM}; pg8::StaticOrder S; S.init(M, NGU, G, bx); pg8::SideXpose sx{(const unsigned long long*)(ws + WS_TAB)};
      pg8::EpiGU<true> E{ACT, FF, STAT, sx};
      pg8::gemm_phase<pg8::EpiGU<true>, pg8::StaticOrder, true, true>(ldsl, g, S, E); }
    GSYNC();
    for (int rep_ = 0; rep_ < REPS(2); ++rep_)
    { pg8::Gemm g{ACT, WD1, M, DM, FF}; pg8::StaticOrder S; S.init(M, DM, G, bx); pg8::EpiRes<false> E{nullptr, XB, STAT1, 0.5f};
      pg8::gemm_phase<pg8::EpiRes<false>, pg8::StaticOrder, true, true>(ldsl, g, S, E); }
    LSYNC();
    for (int rep_ = 0; rep_ < REPS(3); ++rep_)
    { pg8::Gemm g{XB, WIN, M, NIN, DM}; pg8::StaticOrder S; S.init(M, NIN, G, bx); pg8::EpiIn E{H, STAT1, args.in[10], args.in[11], attn_body::C2};
      pg8::gemm_phase<pg8::EpiIn, pg8::StaticOrder, true, true>(ldsl, g, S, E); }
    for (int rep_ = 0; rep_ < REPS(5); ++rep_)
    {
        const int fr = lane & 15, fq = lane >> 4; const int row = vcu * 128 + wave * 16 + fr;
        const u16* ap = XB + (size_t)row * DM + 8 * fq; const u16* bp = WF + (size_t)fr * DM + 8 * fq;
        f32x4 c = (f32x4){0.f, 0.f, 0.f, 0.f};
#pragma unroll 16
        for (int ks = 0; ks < 32; ++ks) c = __builtin_amdgcn_mfma_f32_16x16x32_bf16(*(const bf16x8*)(bp + 32 * ks), *(const bf16x8*)(ap + 32 * ks), c, 0, 0, 0);
        if (fq < 2) { const float rs = pg8::row_rs(STAT1, row); const f32x4 bf = *(const f32x4*)(args.in[7] + 4 * fq); f32x4 o;
#pragma unroll
            for (int i = 0; i < 4; ++i) { const float z = c[i] * rs + bf[i]; o[i] = (z >= 0.f) ? -log1pf(expf(-z)) : (z - log1pf(expf(z))); }
            *(f32x4*)(LOGF + (size_t)row * NH + 4 * fq) = o; }
    }
    LSYNC();
    float aref;
    { float mq = fabsf(args.in[10][lane]), mk = fabsf(args.in[11][lane]);
#pragma unroll
      for (int o_ = 1; o_ < 64; o_ <<= 1) { mq = fmaxf(mq, __shfl_xor(mq, o_)); mk = fmaxf(mk, __shfl_xor(mk, o_)); }
      aref = attn_body::C2 * 64.0f * mq * mk * 1.02f; }
    for (int rep_ = 0; rep_ < REPS(4); ++rep_)
    attn_body::attn_phase<8>((char*)lds, (const attn_body::bf16*)(H + 512), (const attn_body::bf16*)(H + 1024), (const attn_body::bf16*)(H + 1536), (attn_body::bf16*)(Y + 512), LOGF, vcu, aref, ASS);
    for (int rep_ = 0; rep_ < REPS(6); ++rep_)
    {
        const float* pscale = args.in[9]; const float* pgain = args.in[12];
        const int ch = lane * 8, w = 2 << (lane >> 4);
        const f32x4 ps0 = *(const f32x4*)(pscale + ch), ps1 = *(const f32x4*)(pscale + ch + 4), pg0 = *(const f32x4*)(pgain + ch), pg1 = *(const f32x4*)(pgain + ch + 4);
        for (int unit = gw; unit < M / 16; unit += NGW) {
            const int r0 = unit * 16, t0 = r0 % SEQ; const u16* zp = H + (size_t)r0 * 2048 + ch;
            v4u zr[16], mr[16];
#pragma unroll
            for (int i = 0; i < 16; ++i) { zr[i] = *(const v4u*)(zp + (size_t)i * 2048); mr[i] = (t0 + i >= w) ? *(const v4u*)(zp + (size_t)(i - w) * 2048) : (v4u){0u, 0u, 0u, 0u}; }
            float S[8];
#pragma unroll
            for (int e = 0; e < 8; ++e) S[e] = 0.f;
#pragma unroll
            for (int j = 1; j <= 16; ++j) { if (j <= w && j <= t0) { const v4u c = *(const v4u*)(zp - (size_t)j * 2048);
                    S[0] += bflo(c.x); S[1] += bfhi(c.x); S[2] += bflo(c.y); S[3] += bfhi(c.y); S[4] += bflo(c.z); S[5] += bfhi(c.z); S[6] += bflo(c.w); S[7] += bfhi(c.w); } }
#pragma unroll
            for (int hh = 0; hh < 2; ++hh) {
                float y[8][8], q[8];
#pragma unroll
                for (int ii = 0; ii < 8; ++ii) { const int i = 8 * hh + ii, t = t0 + i; const v4u c = zr[i]; float z[8];
                    z[0] = bflo(c.x); z[1] = bfhi(c.x); z[2] = bflo(c.y); z[3] = bfhi(c.y); z[4] = bflo(c.z); z[5] = bfhi(c.z); z[6] = bflo(c.w); z[7] = bfhi(c.w);
                    { const v4u d = mr[i];
                        S[0] += z[0] - bflo(d.x); S[1] += z[1] - bfhi(d.x); S[2] += z[2] - bflo(d.y); S[3] += z[3] - bfhi(d.y); S[4] += z[4] - bflo(d.z); S[5] += z[5] - bfhi(d.z); S[6] += z[6] - bflo(d.w); S[7] += z[7] - bfhi(d.w); }
                    const float inv = __builtin_amdgcn_rcpf((float)((t + 1 < w) ? (t + 1) : w));
                    float qq = 0.f;
#pragma unroll
                    for (int e = 0; e < 8; ++e) { y[ii][e] = (S[e] * inv - z[e]) * (e < 4 ? ps0[e & 3] : ps1[e & 3]); qq += y[ii][e] * y[ii][e]; }
                    q[ii] = qq; }
#define RS_STEP(n, bit) _Pragma("unroll") for (int k = 0; k < (n) / 2; ++k) { const bool up = (lane & (bit)) != 0; const float send = up ? q[k] : q[k + (n) / 2]; const float keep = up ? q[k + (n) / 2] : q[k]; q[k] = keep + __shfl_xor(send, (bit)); }
                RS_STEP(8, 32) RS_STEP(4, 16) RS_STEP(2, 8)
#undef RS_STEP
                float tot = q[0]; tot += __shfl_xor(tot, 4); tot += __shfl_xor(tot, 2); tot += __shfl_xor(tot, 1);
                const float rsl = __builtin_amdgcn_rsqf(tot * (1.0f / 512.0f) + pg8::RMS_EPS);
#pragma unroll
                for (int ii = 0; ii < 8; ++ii) { const float rs = __int_as_float(__builtin_amdgcn_readlane(__float_as_int(rsl), ((ii & 4) ? 32 : 0) + ((ii & 2) ? 16 : 0) + ((ii & 1) ? 8 : 0)));
                    v4u o; o.x = pk2(y[ii][0] * rs * pg0[0], y[ii][1] * rs * pg0[1]); o.y = pk2(y[ii][2] * rs * pg0[2], y[ii][3] * rs * pg0[3]); o.z = pk2(y[ii][4] * rs * pg1[0], y[ii][5] * rs * pg1[1]); o.w = pk2(y[ii][6] * rs * pg1[2], y[ii][7] * rs * pg1[3]);
                    *(v4u*)(Y + (size_t)(r0 + 8 * hh + ii) * 1024 + ch) = o; }
            }
        }
    }
    LSYNC();
    { pg8::Gemm g{Y, WOUT, M, DM, DM}; pg8::StaticOrder S; S.init(M, DM, G, bx); pg8::EpiOut E{XB, STAT2, ASS};
      pg8::gemm_phase<pg8::EpiOut, pg8::StaticOrder, true, true>(ldsl, g, S, E); }
    LSYNC();
    { pg8::Gemm g{XB, WGU2, M, NGU, DM}; pg8::StaticOrder S; S.init(M, NGU, G, bx); pg8::EpiGU<false> E{ACT, FF, STAT2, pg8::SideXpose{}};
      pg8::gemm_phase<pg8::EpiGU<false>, pg8::StaticOrder, true, true>(ldsl, g, S, E); }
    LSYNC();
    for (int rep_ = 0; rep_ < REPS(7); ++rep_)
    { pg8::Gemm g{ACT, WD2, M, DM, FF}; pg8::StaticOrder S; S.init(M, DM, G, bx); pg8::EpiRes<true> E{out, XB, nullptr, 0.5f};
      pg8::gemm_phase<pg8::EpiRes<true>, pg8::StaticOrder, true, true>(ldsl, g, S, E); }
}

extern "C" void kernel_launch(void* const* d_in, const int* in_sizes, int n_in, void* d_out, int out_size, void* d_ws, size_t ws_size, hipStream_t stream) {
    static int grid = 0;
    if (grid == 0) {
        if (n_in != 19 || in_sizes[0] != M * DM || out_size != M * DM || ws_size < WS_END) { fprintf(stderr, "kernel_launch: shape/workspace mismatch (n_in %d, in0 %d, out %d, ws %zu); nothing launched\n", n_in, n_in > 0 ? in_sizes[0] : -1, out_size, ws_size); grid = -1; return; }
        int dev = 0, cus = 0, per_cu = 0;
        if (hipGetDevice(&dev) != hipSuccess || hipDeviceGetAttribute(&cus, hipDeviceAttributeMultiprocessorCount, dev) != hipSuccess) { fprintf(stderr, "kernel_launch: device query failed\n"); grid = -1; return; }
        if (hipFuncSetAttribute((const void*)hymba_fwd, hipFuncAttributeMaxDynamicSharedMemorySize, LDS_BYTES) != hipSuccess) { fprintf(stderr, "kernel_launch: hipFuncSetAttribute failed\n"); grid = -1; return; }
        if (hipOccupancyMaxActiveBlocksPerMultiprocessor(&per_cu, (const void*)hymba_fwd, NWAVES * 64, LDS_BYTES) != hipSuccess || per_cu < 1) { fprintf(stderr, "kernel_launch: occupancy query reports %d blocks per CU\n", per_cu); per_cu = 1; }
        (void)hipGetLastError();
        grid = cus;
    }
    if (grid < 0) return;
    if (hipMemsetAsync((char*)d_ws + WS_CTL, 0, 32768, stream) != hipSuccess) { fprintf(stderr, "kernel_launch: hipMemsetAsync of the barrier words failed; nothing launched\n"); return; }
    Args a{};
    for (int i = 0; i < 19; ++i) a.in[i] = (const float*)d_in[i];
    a.out = (float*)d_out; a.ws = (unsigned char*)d_ws;
    void* kargs[] = {&a};
    const hipError_t e = hipLaunchCooperativeKernel((const void*)hymba_fwd, dim3(grid), dim3(NWAVES * 64), kargs, LDS_BYTES, stream);
    if (e != hipSuccess) fprintf(stderr, "kernel_launch: cooperative launch failed: %s (grid %d)\n", hipGetErrorString(e), grid);
}
```

```cpp
#include <hip/hip_runtime.h>
#include <cstdio>
#include <cstdint>
namespace pg8 {
#define PG8_LAS __attribute__((address_space(3)))
typedef unsigned short bf16_t;
typedef short bf16x8 __attribute__((ext_vector_type(8)));
typedef float f32x4 __attribute__((ext_vector_type(4)));
typedef unsigned u32x4 __attribute__((ext_vector_type(4)));
constexpr int BM = 256, BK = 64, HALF = 128, HTB = HALF * BK * 2  , STAGE_BYTES = 8 * HTB, NXCD = 8, WGM = 4;

__host__ __device__ __forceinline__ int lds_byte(int r, int c) { const int st = (r >> 4) * 2 + (c >> 5), rr = r & 15, cc = c & 31, ob = rr * 64 + cc * 2; return st * 1024 + (ob ^ (((ob >> 9) & 1) << 5)); }
__host__ __device__ __forceinline__ void stage_rc(int b, int& R, int& C) { const int st = b / 1024, sb = b % 1024, swz = sb ^ (((sb >> 9) & 1) << 5); R = (st >> 1) * 16 + swz / 64; C = (st & 1) * 32 + (swz % 64) / 2; }
__host__ __device__ __forceinline__ int perm32(int rho) { const int n = rho >> 4, i = rho & 15; return 8 * (i >> 2) + 4 * n + (i & 3); }

struct Unit { int pm, pn; };
struct Gemm { const bf16_t* A; const bf16_t* Bt; int M, N, K; };

struct StaticOrder {
    int nM, nN, nwg, G, c;
    __host__ __device__ void init(int M, int N, int G_, int c_) { nM = M / BM; nN = N / BM; nwg = nM * nN; G = G_; c = c_; }
    __host__ __device__ bool next(int i, Unit& u) const {
        const long L = (long)i * G + c; if (L >= nwg) return false;
        int wgid = (int)L; { const int q = nwg / NXCD, r = nwg % NXCD, xcd = wgid % NXCD, off = wgid / NXCD; wgid = (xcd < r ? xcd * (q + 1) : r * (q + 1) + (xcd - r) * q) + off; }
        const int nig = WGM * nN, gid = wgid / nig, fm = gid * WGM, gsz = (nM - fm) < WGM ? (nM - fm) : WGM;
        u.pm = fm + ((wgid % nig) % gsz); u.pn = (wgid % nig) / gsz; return true;
    }
    __device__ __forceinline__ void a_ready(const Unit&) const {}
    __device__ __forceinline__ void done(const Unit&) const {}
};

typedef float f32x2cv __attribute__((ext_vector_type(2))); typedef __bf16 bf16x2cv __attribute__((ext_vector_type(2)));
__device__ __forceinline__ unsigned cvt_pk_bf16(float lo, float hi) { const f32x2cv v = {lo, hi}; return __builtin_bit_cast(unsigned, __builtin_convertvector(v, bf16x2cv)); }
typedef float f32x2 __attribute__((ext_vector_type(2)));
constexpr float RMS_EPS = 1e-6f;
__device__ __forceinline__ float rs_of(float sumsq) { return __builtin_amdgcn_rsqf(sumsq * (1.0f / 1024.0f) + RMS_EPS); }
__device__ __forceinline__ float row_rs(const float* stat, int row) { return rs_of(stat[row]); }
__device__ __forceinline__ void stat_preload(const float* stat, int pm, int wr, int lane, float (&pre)[2]) { pre[0] = stat[pm * BM + wr * 64 + lane]; pre[1] = stat[pm * BM + HALF + wr * 64 + lane]; }
__device__ __forceinline__ void tile_rs(const float (&pre)[2], int fr, float (&rs)[2][4]) {
    const float a0 = rs_of(pre[0]), a1 = rs_of(pre[1]);
#pragma unroll
    for (int m = 0; m < 4; ++m) { rs[0][m] = __shfl(a0, m * 16 + fr); rs[1][m] = __shfl(a1, m * 16 + fr); }
}
__device__ __forceinline__ float silu_mul(float g, float u) { return g * u * __builtin_amdgcn_rcpf(1.0f + __builtin_amdgcn_exp2f(g * -1.4426950408889634f)); }
struct SideXpose {
    const unsigned long long* tab;
    static constexpr int T_D = (2816 / 8) * 4, T_IN = (1024 / 8) * 6, T_O = (1024 / 8) * 4, T_GU = (1024 / 8) * 11, TOTAL = 2 * T_D + T_IN + T_O + 2 * T_GU;
    __device__ __forceinline__ void decode(int& r, const float*& W, int& ldw, int& K, int& ntiles, int& ncol0, const float*& gain, bf16_t*& WT, int& mode, int& kmin) const {
        int wi, gi, di; kmin = 0;
        if (r < T_D) { wi = 0; gi = -1; di = 8; ldw = 1024; K = 2816; ntiles = 4; ncol0 = 0; mode = 0; }
        else if ((r -= T_D) < T_IN) { wi = 1; gi = 6; di = 9; ldw = 2056; K = 1024; ntiles = 6; ncol0 = 512; mode = 3; }
        else if ((r -= T_IN) < T_O) { wi = 2; gi = 13; di = 10; ldw = 1024; K = 1024; ntiles = 4; ncol0 = 0; mode = 0; kmin = 512; }
        else if ((r -= T_O) < T_GU) { wi = 3; gi = 7; di = 11; ldw = 2816; K = 1024; ntiles = 11; ncol0 = 0; mode = 1; }
        else if ((r -= T_GU) < T_GU) { wi = 4; gi = 7; di = 11; ldw = 2816; K = 1024; ntiles = 11; ncol0 = 0; mode = 2; }
        else { r -= T_GU; wi = 5; gi = -1; di = 12; ldw = 1024; K = 2816; ntiles = 4; ncol0 = 0; mode = 0; }
        W = (const float*)tab[wi]; gain = gi >= 0 ? (const float*)tab[gi] : nullptr; WT = (bf16_t*)tab[di];
    }
};
template <bool SIDE> struct EpiGU {
    static constexpr bool PERM = true, AFTER_DRAIN = false, MIDK = false, PRELOAD = true;
    bf16_t* O; int ldo; const float* stat; SideXpose sx;
    __device__ __forceinline__ void preload(const Unit& u, int wr, int lane, float (&pre)[2]) const { stat_preload(stat, u.pm, wr, lane, pre); }
    __device__ __forceinline__ void operator()(const f32x4 (&acc)[2][2][4][2], const Unit& u, int wr, int wc, int fr, int fq, const float (&pre)[2]) const {
        const int row0 = u.pm * BM + wr * 64 + fr, col0 = u.pn * HALF + wc * 32 + 8 * fq;
        int sr = ((u.pn * 128 + u.pm) << 3) + wr * 4 + wc; const bool has = SIDE && sr < SideXpose::TOTAL;
        const float* sW = nullptr; const float* sgain = nullptr; bf16_t* sWT = nullptr; int sldw = 0, sK = 0, snt = 1, sn0 = 0, smode = 0, sk0 = 0, sn = 0, skmin = 0;
        f32x4 sv[8];
        if (has) { sx.decode(sr, sW, sldw, sK, snt, sn0, sgain, sWT, smode, skmin);
            const int per = 8 * snt, kb = sr / per, rem = sr % per; sk0 = kb * 64 + (rem & 7) * 8; sn = sn0 + (rem >> 3) * 256 + 4 * (fq * 16 + fr);
#pragma unroll
            for (int i = 0; i < 8; ++i) sv[i] = __builtin_nontemporal_load((const f32x4*)(sW + (size_t)(sk0 + i) * sldw + sn)); }
        float rsv[2][4]; tile_rs(pre, fr, rsv);
#pragma unroll
        for (int ai = 0; ai < 2; ++ai)
#pragma unroll
            for (int m = 0; m < 4; ++m) { const int row = row0 + ai * HALF + m * 16; const float rs = rsv[ai][m];
                const float c1 = rs * -1.4426950408889634f, k = __builtin_amdgcn_rcpf(rs * rs);
                const f32x4 t0 = acc[ai][0][m][0] * c1, t1 = acc[ai][0][m][1] * c1, p0 = acc[ai][0][m][0] * acc[ai][1][m][0], p1 = acc[ai][0][m][1] * acc[ai][1][m][1];
                float o[8];
#pragma unroll
                for (int e = 0; e < 4; ++e) { o[e] = p0[e] * __builtin_amdgcn_rcpf(__builtin_fmaf(__builtin_amdgcn_exp2f(t0[e]), k, k)); o[4 + e] = p1[e] * __builtin_amdgcn_rcpf(__builtin_fmaf(__builtin_amdgcn_exp2f(t1[e]), k, k)); }
                u32x4 w; w.x = cvt_pk_bf16(o[0], o[1]); w.y = cvt_pk_bf16(o[2], o[3]); w.z = cvt_pk_bf16(o[4], o[5]); w.w = cvt_pk_bf16(o[6], o[7]);
                __builtin_nontemporal_store(w, (u32x4*)(O + (size_t)row * ldo + col0)); }
        if (has) {
            if (sgain && sk0 >= skmin) {
#pragma unroll
                for (int i = 0; i < 8; ++i) sv[i] = sv[i] * sgain[sk0 + i]; }
            int drow = sn;
            if (smode == 1 || smode == 2) drow = 256 * (sn / 128) + (sn % 128) + (smode == 2 ? 128 : 0);
            if (smode == 3 && sn < 1536) drow = 256 * (sn / 256) + 128 * ((sn % 64) / 32) + 32 * ((sn % 256) / 64) + (sn % 32);
#pragma unroll
            for (int j = 0; j < 4; ++j) { u32x4 o; o.x = cvt_pk_bf16(sv[0][j], sv[1][j]); o.y = cvt_pk_bf16(sv[2][j], sv[3][j]); o.z = cvt_pk_bf16(sv[4][j], sv[5][j]); o.w = cvt_pk_bf16(sv[6][j], sv[7][j]);
                *(u32x4*)(sWT + (size_t)(drow + j) * sK + sk0) = o; }
        }
    }
};
template <bool OUTF32> struct EpiRes {
    static constexpr bool PERM = true, AFTER_DRAIN = false, MIDK = false, PRELOAD = false;
    float* out; bf16_t* xb; float* stat; float alpha;
    __device__ __forceinline__ void operator()(const f32x4 (&acc)[2][2][4][2], const Unit& u, int wr, int wc, int fr, int fq, const float (&pre)[2]) const {
        const int row0 = u.pm * BM + wr * 64 + fr, col0 = u.pn * BM + wc * 32 + 8 * fq;
#pragma unroll
        for (int ai = 0; ai < 2; ++ai) {
        u32x4 rv[1][4][2];
#pragma unroll
            for (int m = 0; m < 4; ++m)
#pragma unroll
                for (int bj = 0; bj < 2; ++bj) rv[0][m][bj] = *(const u32x4*)(xb + (size_t)(row0 + ai * HALF + m * 16) * 1024 + col0 + bj * HALF);
            asm volatile("" ::: "memory");
#pragma unroll
            for (int m = 0; m < 4; ++m) { const int row = row0 + ai * HALF + m * 16; const size_t off = (size_t)row * 1024 + col0; float ss = 0.f;
#pragma unroll
                for (int bj = 0; bj < 2; ++bj) { const u32x4 r = rv[0][m][bj];
                    const f32x4 b0 = (f32x4){__uint_as_float(r.x << 16), __uint_as_float(r.x & 0xffff0000u), __uint_as_float(r.y << 16), __uint_as_float(r.y & 0xffff0000u)};
                    const f32x4 b1 = (f32x4){__uint_as_float(r.z << 16), __uint_as_float(r.z & 0xffff0000u), __uint_as_float(r.w << 16), __uint_as_float(r.w & 0xffff0000u)};
                    const f32x4 o0 = b0 + acc[ai][bj][m][0] * alpha, o1 = b1 + acc[ai][bj][m][1] * alpha;
                    if (OUTF32) { __builtin_nontemporal_store(o0, (f32x4*)(out + off + bj * HALF)); __builtin_nontemporal_store(o1, (f32x4*)(out + off + bj * HALF + 4)); }
                    else { u32x4 w; w.x = cvt_pk_bf16(o0[0], o0[1]); w.y = cvt_pk_bf16(o0[2], o0[3]); w.z = cvt_pk_bf16(o1[0], o1[1]); w.w = cvt_pk_bf16(o1[2], o1[3]);
                        *(u32x4*)(xb + off + bj * HALF) = w;
                        ss += ((o0[0] * o0[0] + o0[1] * o0[1]) + (o0[2] * o0[2] + o0[3] * o0[3])) + ((o1[0] * o1[0] + o1[1] * o1[1]) + (o1[2] * o1[2] + o1[3] * o1[3])); } }
                if (!OUTF32) { ss += __shfl_xor(ss, 16); ss += __shfl_xor(ss, 32); if (fq == 0) unsafeAtomicAdd(stat + row, ss); } }
        }
    }
};
struct EpiOut {
    static constexpr bool PERM = true, AFTER_DRAIN = false, MIDK = true, PRELOAD = true;
    bf16_t* xb; float* stat; const float* ss;
    __device__ __forceinline__ void preload(const Unit& u, int wr, int lane, float (&pre)[2]) const { stat_preload(ss, u.pm, wr, lane, pre); }
    __device__ __forceinline__ void scales(const float (&pre)[2], int lane, bool inv, float (&sc)[2][4]) const {
        const float v0 = pre[0] * (1.0f / 512.0f) + RMS_EPS, v1 = pre[1] * (1.0f / 512.0f) + RMS_EPS;
        const float a0 = inv ? __builtin_amdgcn_sqrtf(v0) : __builtin_amdgcn_rsqf(v0), a1 = inv ? __builtin_amdgcn_sqrtf(v1) : __builtin_amdgcn_rsqf(v1); const int fr = lane & 15;
#pragma unroll
        for (int m = 0; m < 4; ++m) { sc[0][m] = __shfl(a0, m * 16 + fr); sc[1][m] = __shfl(a1, m * 16 + fr); }
    }
    __device__ __forceinline__ void midk(f32x4 (&acc)[2][2][4][2], const float (&pre)[2], int lane) const {
        float sc[2][4]; scales(pre, lane, true, sc);
#pragma unroll
        for (int ai = 0; ai < 2; ++ai)
#pragma unroll
            for (int bj = 0; bj < 2; ++bj)
#pragma unroll
                for (int m = 0; m < 4; ++m)
#pragma unroll
                    for (int n = 0; n < 2; ++n) acc[ai][bj][m][n] = acc[ai][bj][m][n] * sc[ai][m];
    }
    __device__ __forceinline__ void operator()(const f32x4 (&acc)[2][2][4][2], const Unit& u, int wr, int wc, int fr, int fq, const float (&pre)[2]) const {
        const int row0 = u.pm * BM + wr * 64 + fr, col0 = u.pn * BM + wc * 32 + 8 * fq;
        float sc[2][4]; scales(pre, fq * 16 + fr, false, sc);
#pragma unroll
        for (int ai = 0; ai < 2; ++ai) {
        u32x4 rv[4][2];
#pragma unroll
            for (int m = 0; m < 4; ++m)
#pragma unroll
                for (int bj = 0; bj < 2; ++bj) rv[m][bj] = *(const u32x4*)(xb + (size_t)(row0 + ai * HALF + m * 16) * 1024 + col0 + bj * HALF);
            asm volatile("" ::: "memory");
#pragma unroll
            for (int m = 0; m < 4; ++m) { const int row = row0 + ai * HALF + m * 16; const size_t off = (size_t)row * 1024 + col0; float ss_ = 0.f; const float s = sc[ai][m];
#pragma unroll
                for (int bj = 0; bj < 2; ++bj) { const u32x4 r = rv[m][bj];
                    const f32x4 b0 = (f32x4){__uint_as_float(r.x << 16), __uint_as_float(r.x & 0xffff0000u), __uint_as_float(r.y << 16), __uint_as_float(r.y & 0xffff0000u)};
                    const f32x4 b1 = (f32x4){__uint_as_float(r.z << 16), __uint_as_float(r.z & 0xffff0000u), __uint_as_float(r.w << 16), __uint_as_float(r.w & 0xffff0000u)};
                    const f32x4 o0 = b0 + acc[ai][bj][m][0] * s, o1 = b1 + acc[ai][bj][m][1] * s;
                    u32x4 w; w.x = cvt_pk_bf16(o0[0], o0[1]); w.y = cvt_pk_bf16(o0[2], o0[3]); w.z = cvt_pk_bf16(o1[0], o1[1]); w.w = cvt_pk_bf16(o1[2], o1[3]);
                    *(u32x4*)(xb + off + bj * HALF) = w;
                    ss_ += ((o0[0] * o0[0] + o0[1] * o0[1]) + (o0[2] * o0[2] + o0[3] * o0[3])) + ((o1[0] * o1[0] + o1[1] * o1[1]) + (o1[2] * o1[2] + o1[3] * o1[3])); }
                ss_ += __shfl_xor(ss_, 16); ss_ += __shfl_xor(ss_, 32); if (fq == 0) unsafeAtomicAdd(stat + row, ss_); }
        }
    }
};
struct EpiIn {
    static constexpr bool PERM = true, AFTER_DRAIN = false, MIDK = false, PRELOAD = true;
    bf16_t* H; const float* stat; const float* qg; const float* kg; float qscale;
    __device__ __forceinline__ void preload(const Unit& u, int wr, int lane, float (&pre)[2]) const { stat_preload(stat, u.pm, wr, lane, pre); }
    __device__ __forceinline__ void operator()(const f32x4 (&acc)[2][2][4][2], const Unit& u, int wr, int wc, int fr, int fq, const float (&pre)[2]) const {
        const int row0 = u.pm * BM + wr * 64 + fr; const int pn = u.pn; const bool hp = (pn >= 2 && pn < 6);
        float rsv[2][4]; tile_rs(pre, fr, rsv);
        if (!hp) { const int col0 = pn * BM + wc * 32 + 8 * fq;
#pragma unroll
            for (int ai = 0; ai < 2; ++ai)
#pragma unroll
                for (int m = 0; m < 4; ++m) { const int row = row0 + ai * HALF + m * 16; const float rs = rsv[ai][m];
#pragma unroll
                    for (int bj = 0; bj < 2; ++bj) { const f32x4 v0 = acc[ai][bj][m][0] * rs, v1 = acc[ai][bj][m][1] * rs;
                        u32x4 w; w.x = cvt_pk_bf16(v0[0], v0[1]); w.y = cvt_pk_bf16(v0[2], v0[3]); w.z = cvt_pk_bf16(v1[0], v1[1]); w.w = cvt_pk_bf16(v1[2], v1[3]);
                        *(u32x4*)(H + (size_t)row * 2048 + col0 + bj * HALF) = w; } }
        } else { const float* g = (pn < 4) ? qg : kg; const float sc = (pn < 4) ? qscale : 1.0f; const int col0 = pn * BM + wc * 64 + 8 * fq;
            f32x4 gv[2][2];
#pragma unroll
            for (int bj = 0; bj < 2; ++bj)
#pragma unroll
                for (int n = 0; n < 2; ++n) gv[bj][n] = *(const f32x4*)(g + 32 * bj + 8 * fq + 4 * n) * sc;
#pragma unroll
            for (int ai = 0; ai < 2; ++ai)
#pragma unroll
                for (int m = 0; m < 4; ++m) { const int row = row0 + ai * HALF + m * 16; const float rs = rsv[ai][m];
                    float ss = 0.f;
#pragma unroll
                    for (int bj = 0; bj < 2; ++bj)
#pragma unroll
                        for (int n = 0; n < 2; ++n) { const f32x4 x = acc[ai][bj][m][n]; ss += (x[0] * x[0] + x[1] * x[1]) + (x[2] * x[2] + x[3] * x[3]); }
                    ss += __shfl_xor(ss, 16); ss += __shfl_xor(ss, 32);
                    const float r = __builtin_amdgcn_rsqf(ss * (1.0f / 64.0f) + RMS_EPS * __builtin_amdgcn_rcpf(rs * rs));
#pragma unroll
                    for (int bj = 0; bj < 2; ++bj) { const f32x4 v0 = acc[ai][bj][m][0] * (gv[bj][0] * r), v1 = acc[ai][bj][m][1] * (gv[bj][1] * r);
                        u32x4 w; w.x = cvt_pk_bf16(v0[0], v0[1]); w.y = cvt_pk_bf16(v0[2], v0[3]); w.z = cvt_pk_bf16(v1[0], v1[1]); w.w = cvt_pk_bf16(v1[2], v1[3]);
                        *(u32x4*)(H + (size_t)row * 2048 + col0 + bj * 32) = w; } }
        }
    }
};
template <class Epi, class Sched, bool ALIGN_EPI = false, bool SP2 = false>
__device__ __forceinline__ void gemm_phase(PG8_LAS unsigned char* lds, const Gemm g, const Sched& S, const Epi& E) {
    int tid_ = threadIdx.x; asm volatile("" : "+v"(tid_));
    const int tid = tid_, wid = __builtin_amdgcn_readfirstlane(tid >> 6), lane = tid & 63, wr = wid >> 2, wc = wid & 3, fr = lane & 15, fq = lane >> 4;
    const int K = g.K, nt = K / BK;
    unsigned voffA[2], voffB[2];
#pragma unroll
    for (int i = 0; i < 2; ++i) { int R, C; stage_rc(tid * 16 + i * 8192, R, C); const int Rb = Epi::PERM ? ((R & ~31) + perm32(R & 31)) : R;
        voffA[i] = (unsigned)(R * K + C) * 2u; voffB[i] = (unsigned)(Rb * K + C) * 2u; }
    const size_t kstep = (size_t)(BK * 2);
    const size_t hstep = (size_t)HALF * K * 2;
    const size_t tstep = 2 * hstep;
    const unsigned ldsw = (unsigned)wid * 1024u;
    const int aoff = lds_byte(wr * 64 + fr, fq * 8), boff = lds_byte(wc * 32 + fr, fq * 8);
#define PG8_SA(b, h) (((b) * 2 + (h)) * HTB)
#define PG8_SB(b, h) ((4 + (b) * 2 + (h)) * HTB)
#define PG8_STAGE(bufoff, gbase, voff) do { _Pragma("unroll") for (int _i = 0; _i < 2; ++_i) \
        __builtin_amdgcn_global_load_lds((const unsigned*)((const char*)(gbase) + (voff)[_i]), (PG8_LAS unsigned*)(lds + (bufoff) + ldsw + _i * 8192), 16, 0, 0); } while (0)
#define PG8_LDA(dst, b, h) do { _Pragma("unroll") for (int m = 0; m < 4; ++m) _Pragma("unroll") for (int k = 0; k < 2; ++k) dst[m][k] = *(const PG8_LAS bf16x8*)(lds + PG8_SA(b, h) + aoff + m * 2048 + k * 1024); } while (0)
#define PG8_LDB(dst, b, h) do { _Pragma("unroll") for (int n = 0; n < 2; ++n) _Pragma("unroll") for (int k = 0; k < 2; ++k) dst[n][k] = *(const PG8_LAS bf16x8*)(lds + PG8_SB(b, h) + boff + n * 2048 + k * 1024); } while (0)
#define PG8_MMA(ai, bj, At, Bt) do { __builtin_amdgcn_s_setprio(1); _Pragma("unroll") for (int m = 0; m < 4; ++m) _Pragma("unroll") for (int n = 0; n < 2; ++n) _Pragma("unroll") for (int k = 0; k < 2; ++k) \
        acc[ai][bj][m][n] = __builtin_amdgcn_mfma_f32_16x16x32_bf16(Bt[n][k], At[m][k], acc[ai][bj][m][n], 0, 0, 0); __builtin_amdgcn_s_setprio(0); } while (0)
#define PG8_WAIT_V(n) asm volatile("s_waitcnt vmcnt(" #n ")" ::: "memory")
#define PG8_WAIT_L(n) asm volatile("s_waitcnt lgkmcnt(" #n ")" ::: "memory")
#define PG8_BAR __builtin_amdgcn_s_barrier()
#define PG8_SCHED __builtin_amdgcn_sched_barrier(0)
    Unit cur, nxt; int ui = 0;
    if (!S.next(0, cur)) return;
    f32x4 acc[2][2][4][2];
#pragma unroll
    for (int a = 0; a < 2; ++a)
#pragma unroll
        for (int b = 0; b < 2; ++b)
#pragma unroll
            for (int m = 0; m < 4; ++m)
#pragma unroll
                for (int n = 0; n < 2; ++n) acc[a][b][m][n] = (f32x4){0.f, 0.f, 0.f, 0.f};
    bf16x8 At[4][2], B0[2][2], B1[2][2];
    const char* cA = (const char*)g.A + (size_t)cur.pm * tstep; const char* cB = (const char*)g.Bt + (size_t)cur.pn * tstep;
    float pre[2] = {0.f, 0.f};
    if constexpr (Epi::PRELOAD) E.preload(cur, wr, lane, pre);
    S.a_ready(cur);
    if constexpr (SP2) {
        PG8_STAGE(PG8_SB(0, 0), cB, voffB); PG8_STAGE(PG8_SB(0, 1), cB + hstep, voffB); PG8_STAGE(PG8_SA(0, 0), cA, voffA); PG8_STAGE(PG8_SA(0, 1), cA + hstep, voffA);
        if (wr == 1) PG8_BAR;
        PG8_WAIT_V(2); PG8_BAR;
        PG8_STAGE(PG8_SB(1, 0), cB + kstep, voffB); PG8_STAGE(PG8_SA(1, 0), cA + kstep, voffA); PG8_STAGE(PG8_SB(1, 1), cB + hstep + kstep, voffB);
        PG8_WAIT_V(6); PG8_BAR;
    } else {
        PG8_STAGE(PG8_SB(0, 0), cB, voffB); PG8_STAGE(PG8_SA(0, 0), cA, voffA); PG8_STAGE(PG8_SB(0, 1), cB + hstep, voffB); PG8_STAGE(PG8_SA(0, 1), cA + hstep, voffA);
        if (wr == 1) PG8_BAR;
        PG8_WAIT_V(4); PG8_BAR;
        PG8_STAGE(PG8_SB(1, 0), cB + kstep, voffB); PG8_STAGE(PG8_SA(1, 0), cA + kstep, voffA); PG8_STAGE(PG8_SB(1, 1), cB + hstep + kstep, voffB);
        PG8_WAIT_V(6); PG8_BAR;
    }
    for (;;) {
        const bool has_next = S.next(ui + 1, nxt);
        const char* nA = has_next ? (const char*)g.A + (size_t)nxt.pm * tstep : cA; const char* nB = has_next ? (const char*)g.Bt + (size_t)nxt.pn * tstep : cB;
        for (int t = 0; t < nt; t += 2) {
            if constexpr (Epi::MIDK) { if (t == nt / 2) E.midk(acc, pre, lane); }
            const bool last = (t == nt - 2);
            const char* a1 = cA + (size_t)(t + 1) * kstep;
            const char* a2 = last ? nA : cA + (size_t)(t + 2) * kstep; const char* b2 = last ? nB : cB + (size_t)(t + 2) * kstep;
            const char* a3 = a2 + kstep; const char* b3 = b2 + kstep;
            if (last && has_next) S.a_ready(nxt);
            if constexpr (SP2) {
            PG8_LDB(B0, 0, 0); PG8_LDB(B1, 0, 1); PG8_SCHED; PG8_LDA(At, 0, 0); PG8_STAGE(PG8_SA(1, 1), a1 + hstep, voffA);
            PG8_WAIT_V(8); PG8_WAIT_L(0); PG8_BAR; PG8_MMA(0, 0, At, B0); PG8_MMA(0, 1, At, B1); PG8_BAR; PG8_SCHED;
            PG8_LDA(At, 0, 1); PG8_STAGE(PG8_SB(0, 0), b2, voffB); PG8_STAGE(PG8_SB(0, 1), b2 + hstep, voffB); PG8_STAGE(PG8_SA(0, 0), a2, voffA);
            PG8_WAIT_V(8); PG8_WAIT_L(0); PG8_BAR; PG8_MMA(1, 0, At, B0); PG8_MMA(1, 1, At, B1); PG8_BAR; PG8_SCHED;
            PG8_LDB(B0, 1, 0); PG8_LDB(B1, 1, 1); PG8_SCHED; PG8_LDA(At, 1, 0); PG8_STAGE(PG8_SA(0, 1), a2 + hstep, voffA);
            PG8_WAIT_V(8); PG8_WAIT_L(0); PG8_BAR; PG8_MMA(0, 0, At, B0); PG8_MMA(0, 1, At, B1); PG8_BAR; PG8_SCHED;
            PG8_LDA(At, 1, 1); PG8_STAGE(PG8_SB(1, 0), b3, voffB); PG8_STAGE(PG8_SB(1, 1), b3 + hstep, voffB); PG8_STAGE(PG8_SA(1, 0), a3, voffA);
            PG8_WAIT_V(8); PG8_WAIT_L(0); PG8_BAR; PG8_MMA(1, 0, At, B0); PG8_MMA(1, 1, At, B1); PG8_BAR; PG8_SCHED;
            } else {
            PG8_LDB(B0, 0, 0); PG8_SCHED; PG8_LDA(At, 0, 0); PG8_STAGE(PG8_SA(1, 1), a1 + hstep, voffA);
            PG8_WAIT_L(8); PG8_BAR; PG8_WAIT_L(0); PG8_MMA(0, 0, At, B0); PG8_BAR; PG8_SCHED;
            PG8_LDB(B1, 0, 1); PG8_STAGE(PG8_SB(0, 0), b2, voffB);
            PG8_BAR; PG8_WAIT_L(0); PG8_MMA(0, 1, At, B1); PG8_BAR;
            PG8_LDA(At, 0, 1); PG8_STAGE(PG8_SA(0, 0), a2, voffA);
            PG8_BAR; PG8_WAIT_L(0); PG8_MMA(1, 0, At, B0); PG8_BAR; PG8_SCHED;
            PG8_STAGE(PG8_SB(0, 1), b2 + hstep, voffB);
            PG8_WAIT_V(6); PG8_BAR; PG8_MMA(1, 1, At, B1); PG8_BAR;
            PG8_LDB(B0, 1, 0); PG8_SCHED; PG8_LDA(At, 1, 0); PG8_STAGE(PG8_SA(0, 1), a2 + hstep, voffA);
            PG8_WAIT_L(8); PG8_BAR; PG8_WAIT_L(0); PG8_MMA(0, 0, At, B0); PG8_BAR; PG8_SCHED;
            PG8_LDB(B1, 1, 1); PG8_STAGE(PG8_SB(1, 0), b3, voffB);
            PG8_BAR; PG8_WAIT_L(0); PG8_MMA(0, 1, At, B1); PG8_BAR;
            PG8_LDA(At, 1, 1); PG8_STAGE(PG8_SA(1, 0), a3, voffA);
            PG8_BAR; PG8_WAIT_L(0); PG8_MMA(1, 0, At, B0); PG8_BAR; PG8_SCHED;
            PG8_STAGE(PG8_SB(1, 1), b3 + hstep, voffB);
            PG8_WAIT_V(6); PG8_BAR; PG8_MMA(1, 1, At, B1); PG8_BAR;
            }
        }
        if constexpr (ALIGN_EPI) { if (wr == 0) PG8_BAR; }
        if constexpr (!Epi::AFTER_DRAIN) { E(acc, cur, wr, wc, fr, fq, pre); S.done(cur); }
        if (!has_next) break;
#pragma unroll
        for (int a = 0; a < 2; ++a)
#pragma unroll
            for (int b = 0; b < 2; ++b)
#pragma unroll
                for (int m = 0; m < 4; ++m)
#pragma unroll
                    for (int n = 0; n < 2; ++n) acc[a][b][m][n] = (f32x4){0.f, 0.f, 0.f, 0.f};
        cur = nxt; cA = nA; cB = nB; ++ui;
        if constexpr (Epi::PRELOAD) E.preload(cur, wr, lane, pre);
        if constexpr (ALIGN_EPI) { if (wr == 1) PG8_BAR; }
    }
    PG8_WAIT_V(0);
    if constexpr (!ALIGN_EPI) { if (wr == 0) PG8_BAR; }
    PG8_BAR;
    if constexpr (Epi::AFTER_DRAIN) { E.fused(acc, cur, wr, wc, fr, fq, lds, wid, lane); S.done(cur); }
#undef PG8_SA
#undef PG8_SB
#undef PG8_STAGE
#undef PG8_LDA
#undef PG8_LDB
#undef PG8_MMA
#undef PG8_WAIT_V
#undef PG8_WAIT_L
#undef PG8_BAR
#undef PG8_SCHED
}
}

#ifndef PG8_SP2
#define PG8_SP2 true
#endif
#ifndef PG8_ALIGN
#define PG8_ALIGN true
#endif
#include <hip/hip_bf16.h>
#include <cmath>
namespace attn_body {
using bf16=__hip_bfloat16;
using bf16x8=__attribute__((ext_vector_type(8)))short;
using s16x4=__attribute__((ext_vector_type(4)))short;
using f32x16=__attribute__((ext_vector_type(16)))float;
using u32x4=__attribute__((ext_vector_type(4)))unsigned;
constexpr int BATCH=16,NHEAD=8,SEQ=2048,D=64,QPITCH=2048,OPITCH=1024;
constexpr int NW=8,QBLK=32,QB=QBLK*NW,KVBLK=64,NQB=SEQ/QB;
constexpr int ATTN_UNIT_ROWS=QB;
__device__ __forceinline__ int crow(int r,int hi){return (r&3)+8*(r>>2)+4*hi;}
#define SBAR() __builtin_amdgcn_sched_barrier(0)
__device__ __forceinline__ void cmask(f32x16&p0,f32x16&p1,int jb,int qrel,int hi){
  const float NEG=-INFINITY; int kb=64*jb+4*hi;
  #pragma unroll
  for(int r=0;r<16;++r){int kv=kb+(r&3)+8*(r>>2); if(kv>qrel)p0[r]=NEG; if(kv+32>qrel)p1[r]=NEG;}
}

constexpr int NSLOT=3, SLOTB=8192;
constexpr int LDS_K=0, LDS_V=NSLOT*SLOTB, LDS_WS=2*NSLOT*SLOTB, LDS_OST=LDS_WS+NW*64*4, LDS_BYTES=LDS_OST+NW*4096;
constexpr float C2=0.125f*1.4426950408889634f;
__device__ __forceinline__ void glds16(const void*gsrc,unsigned lds_dst){unsigned keep;
  asm volatile("s_mov_b32 %0, m0\n\ts_mov_b32 m0, %2\n\ts_nop 0\n\tglobal_load_lds_dwordx4 %1, off\n\ts_mov_b32 m0, %0":"=&s"(keep):"v"(gsrc),"s"(lds_dst):"memory");}
__device__ __forceinline__ float max3f(float a,float b,float c){float r;asm("v_max3_f32 %0, %1, %2, %3":"=v"(r):"v"(a),"v"(b),"v"(c));return r;}
__device__ __forceinline__ float max2f(float a,float b){float r;asm("v_max_f32_e32 %0, %1, %2":"=v"(r):"v"(a),"v"(b));return r;}
__device__ __forceinline__ float fadd_s(float a,float b){float r;asm("v_add_f32_e32 %0, %1, %2":"=v"(r):"v"(a),"v"(b));return r;}
__device__ __forceinline__ float fsub_s(float a,float b){float r;asm("v_sub_f32_e32 %0, %1, %2":"=v"(r):"v"(a),"v"(b));return r;}
typedef float f32x2_t __attribute__((ext_vector_type(2))); typedef __bf16 bf16x2_t __attribute__((ext_vector_type(2)));
__device__ __forceinline__ unsigned cvtpk_s(float lo,float hi){f32x2_t v={lo,hi};bf16x2_t b=__builtin_convertvector(v,bf16x2_t);return __builtin_bit_cast(unsigned,b);}
#define WAIT_BAR(N) asm volatile("s_waitcnt vmcnt(" #N ") lgkmcnt(0)\n\ts_barrier":::"memory")

__device__ __forceinline__ void qkt(f32x16&p0,f32x16&p1,const char*Kslot,const bf16x8*qr,int r32,int hi){
  const char*kb=Kslot+hi*1024+r32*16;
  #pragma unroll
  for(int d0=0;d0<4;++d0){
    const bf16x8 b0=*reinterpret_cast<const bf16x8*>(kb+d0*2048);
    const bf16x8 b1=*reinterpret_cast<const bf16x8*>(kb+d0*2048+512);
    p0=__builtin_amdgcn_mfma_f32_32x32x16_bf16(b0,qr[d0],p0,0,0,0);p1=__builtin_amdgcn_mfma_f32_32x32x16_bf16(b1,qr[d0],p1,0,0,0);}
}
typedef __attribute__((address_space(3))) const char* lds_cptr;
typedef short v4i16_t __attribute__((ext_vector_type(4)));
__device__ __forceinline__ void kload8(bf16x8*kf,lds_cptr kp){
  kf[0]=*(const __attribute__((address_space(3))) bf16x8*)(kp);      kf[1]=*(const __attribute__((address_space(3))) bf16x8*)(kp+512);
  kf[2]=*(const __attribute__((address_space(3))) bf16x8*)(kp+2048); kf[3]=*(const __attribute__((address_space(3))) bf16x8*)(kp+2560);
  kf[4]=*(const __attribute__((address_space(3))) bf16x8*)(kp+4096); kf[5]=*(const __attribute__((address_space(3))) bf16x8*)(kp+4608);
  kf[6]=*(const __attribute__((address_space(3))) bf16x8*)(kp+6144); kf[7]=*(const __attribute__((address_space(3))) bf16x8*)(kp+6656);
}
__device__ __forceinline__ void kload2(bf16x8*kf,lds_cptr kp,int j){ kf[2*j]=*(const __attribute__((address_space(3))) bf16x8*)(kp+j*2048); kf[2*j+1]=*(const __attribute__((address_space(3))) bf16x8*)(kp+j*2048+512); }
__device__ __forceinline__ s16x4 vtr(lds_cptr p){ return __builtin_bit_cast(s16x4,__builtin_amdgcn_ds_read_tr16_b64_v4i16((__attribute__((address_space(3))) v4i16_t*)p)); }
__device__ __forceinline__ float rowmax(const f32x16&p0,const f32x16&p1){
  float a=max3f(p0[0],p0[1],p1[0]),b=max3f(p0[2],p0[3],p1[1]);a=max3f(a,p1[2],p1[3]);
  #pragma unroll
  for(int r=4;r<16;r+=4){a=max3f(a,p0[r],p0[r+1]);b=max3f(b,p0[r+2],p0[r+3]);a=max3f(a,p1[r],p1[r+1]);b=max3f(b,p1[r+2],p1[r+3]);}
  const float m=max2f(a,b);
  auto rr=__builtin_amdgcn_permlane32_swap(__float_as_uint(m),__float_as_uint(m),false,false);
  return max2f(__uint_as_float(rr[0]),__uint_as_float(rr[1]));
}
__device__ __forceinline__ void pv(f32x16*o,int vb,bf16x8 pa0,bf16x8 pa1,bf16x8 pa2,bf16x8 pa3){
  #pragma unroll
  for(int d0=0;d0<2;++d0){s16x4 lo[4],hi[4];
    #pragma unroll
    for(int ks=0;ks<4;++ks){
      asm volatile("ds_read_b64_tr_b16 %0,%1 offset:%c2":"=&v"(lo[ks]):"v"(vb),"i"(d0*4096+ks*1024):"memory");
      asm volatile("ds_read_b64_tr_b16 %0,%1 offset:%c2":"=&v"(hi[ks]):"v"(vb),"i"(d0*4096+ks*1024+512):"memory");}
    asm volatile("s_waitcnt lgkmcnt(0)":::"memory");SBAR();
    #define PK(k) (bf16x8){lo[k][0],lo[k][1],lo[k][2],lo[k][3],hi[k][0],hi[k][1],hi[k][2],hi[k][3]}
    o[d0]=__builtin_amdgcn_mfma_f32_32x32x16_bf16(pa0,PK(0),o[d0],0,0,0);
    o[d0]=__builtin_amdgcn_mfma_f32_32x32x16_bf16(pa1,PK(1),o[d0],0,0,0);
    o[d0]=__builtin_amdgcn_mfma_f32_32x32x16_bf16(pa2,PK(2),o[d0],0,0,0);
    o[d0]=__builtin_amdgcn_mfma_f32_32x32x16_bf16(pa3,PK(3),o[d0],0,0,0);
    #undef PK
  }
}

#ifndef ATTN_STORE16
#define ATTN_STORE16(p,v) (*(u32x4*)(p)=(v))
#endif
template<int THRL> __device__ __forceinline__ void attn_unit(int b,int h,int qb,const bf16*Q,const bf16*__restrict__ K,const bf16*__restrict__ V,bf16*O,char*shm,const __attribute__((address_space(3))) float*F2,const float REF,float*SS){
  int tid_=threadIdx.x; asm volatile("":"+v"(tid_)); const int tid=tid_,lane=tid&63,r32=lane&31,hi=lane>>5; const int wid=__builtin_amdgcn_readfirstlane(tid>>6);
  const long rowbase=(long)b*SEQ; const int q0=qb*QB;
  const bf16*Qw=Q+(rowbase+q0+wid*QBLK)*QPITCH+h*D;
  const bf16*Kh=K+rowbase*QPITCH+h*D,*Vh=V+rowbase*QPITCH+h*D;
  const unsigned lds0=(unsigned)(uintptr_t)shm;
  float*wsf=(float*)(shm+LDS_WS)+wid*64;
  const bf16*ksrc=Kh+(long)lane*QPITCH+wid*8;
  const bf16*vsrc=Vh+(long)(16*(wid&3)+(lane>>2))*QPITCH+(wid>>2)*32+(lane&3)*8;
  const unsigned kdst=lds0+LDS_K+wid*1024, vdst=lds0+LDS_V+wid*1024;
  #define DMA_K(t,slot) glds16(ksrc+(long)(t)*KVBLK*QPITCH,(unsigned)__builtin_amdgcn_readfirstlane(kdst+(slot)))
  #define DMA_V(t,slot) glds16(vsrc+(long)(t)*KVBLK*QPITCH,(unsigned)__builtin_amdgcn_readfirstlane(vdst+(slot)))
  const int vb0=(int)(lds0+LDS_V)+((lane>>4)&1)*32+(lane&3)*8+(4*hi+((lane&15)>>2))*64;
  const char*Kbase=shm+LDS_K; bf16x8 kf[8];
  const lds_cptr shm3=(lds_cptr)shm; const lds_cptr kp0=shm3+LDS_K+hi*1024+r32*16; const lds_cptr vp0=shm3+LDS_V+((lane>>4)&1)*32+(lane&3)*8+(4*hi+((lane&15)>>2))*64;
  const int NT=(q0+QB)/KVBLK;
  DMA_K(0,0);DMA_V(0,0);DMA_K(1,SLOTB);
  bf16x8 qr[4];
  #pragma unroll
  for(int d0=0;d0<4;++d0)qr[d0]=*reinterpret_cast<const bf16x8*>(&Qw[(long)r32*QPITCH+d0*16+hi*8]);
  float l_reg=0.f;f32x16 o[2];o[0]=f32x16{};o[1]=f32x16{};
  const int qrel=wid*QBLK+r32;
  const float cq=F2[q0+qrel]-REF;
  typedef float f32x4b __attribute__((ext_vector_type(4)));
  #define CINIT(P0,P1,t) do{ const __attribute__((address_space(3))) float* fb_=F2+64*(t)+4*hi; const float nm_=cq; \
    _Pragma("unroll") for(int g_=0;g_<4;++g_){ const f32x4b a_=*(const __attribute__((address_space(3))) f32x4b*)(fb_+8*g_); const f32x4b b_=*(const __attribute__((address_space(3))) f32x4b*)(fb_+32+8*g_); \
      _Pragma("unroll") for(int i_=0;i_<4;++i_){ P0[4*g_+i_]=nm_-a_[i_]; P1[4*g_+i_]=nm_-b_[i_]; } SBAR(); } }while(0)
  #define CMASK(P0,P1,t) do{int jb_=(t)-(NT-4); if(jb_>=0)cmask(P0,P1,jb_,qrel,hi);}while(0)
  #define RESC() do{}while(0)
  f32x16 pA0,pA1,pB0,pB1;
  int sl_prev=0,sl_cur=0,sl_next=SLOTB;
  #define ROT() do{sl_prev=sl_cur;sl_cur=sl_next;sl_next=(sl_next==(NSLOT-1)*SLOTB)?0:sl_next+SLOTB;}while(0)
  DMA_K(2,2*SLOTB);
  WAIT_BAR(3);
  CINIT(pA0,pA1,0);qkt(pA0,pA1,Kbase,qr,r32,hi);asm volatile("s_nop 15\n\ts_nop 7":"+v"(pA0),"+v"(pA1));CMASK(pA0,pA1,0);
  _Pragma("unroll") for(int r=0;r<16;++r){pA0[r]=__builtin_amdgcn_exp2f(pA0[r]);pA1[r]=__builtin_amdgcn_exp2f(pA1[r]);}
  WAIT_BAR(0);
  DMA_K(3,0);DMA_V(1,SLOTB);
  ROT();
  kload8(kf,kp0+sl_cur);
  WAIT_BAR(2);
  s16x4 vlo[8],vhi[8]; u32x4 pw0,pw1,pw2,pw3;
  #define PKW(P,B) cvtpk_s(P[B],P[B+1])
  #define PAF(k) __builtin_bit_cast(bf16x8,pw##k)
  #define VFR(i) (bf16x8){vlo[i][0],vlo[i][1],vlo[i][2],vlo[i][3],vhi[i][0],vhi[i][1],vhi[i][2],vhi[i][3]}
  #define PIN(x) asm volatile("":"+v"(x))
  #define MX3(a,b,c) __builtin_fmaxf(__builtin_fmaxf((a),(b)),(c))
  #define GAPA(MF,A0,A1,A2,A3,W0,W1,PW) do{ MF; sacc+=A0; sacc+=A1; sacc+=A2; sacc+=A3; PIN(sacc); W0; W1; PIN(PW); SBAR(); }while(0)
  #define EX(v) __builtin_amdgcn_exp2f(v)
  #define GAPB(MF,X,B) do{ MF; X[B]=EX(X[B]); X[B+1]=EX(X[B+1]); X[B+2]=EX(X[B+2]); X[B+3]=EX(X[B+3]); PIN(X); SBAR(); }while(0)
  #define VRD(i) do{ vlo[i]=vtr(vp_+(((i)>>2)*4096+((i)&3)*1024)); vhi[i]=vtr(vp_+(((i)>>2)*4096+((i)&3)*1024+512)); }while(0)
  #define KRD(G,j) do{ if(G){ kload2(kf,kp0+sl_next,j); SBAR(); } }while(0)
  #define STEP(C0,C1,P0,P1,t,GK,GV,GL) do{ SBAR(); CINIT(C0,C1,t); SBAR(); \
    const lds_cptr vp_=vp0+sl_prev; \
    VRD(0); SBAR(); float sacc=(P0[0]+P0[1]); \
    GAPA(C0=__builtin_amdgcn_mfma_f32_32x32x16_bf16(kf[0],qr[0],C0,0,0,0), P0[2],P0[3],P0[4],P0[5],     pw0[0]=PKW(P0,0), pw0[1]=PKW(P0,2), pw0); \
    VRD(4); SBAR(); GAPA(C1=__builtin_amdgcn_mfma_f32_32x32x16_bf16(kf[1],qr[0],C1,0,0,0), P0[6],P0[7],P0[8],P0[9],     pw0[2]=PKW(P0,4), pw0[3]=PKW(P0,6), pw0); \
    VRD(1); SBAR(); GAPA(C0=__builtin_amdgcn_mfma_f32_32x32x16_bf16(kf[2],qr[1],C0,0,0,0),   P0[10],P0[11],P0[12],P0[13], pw1[0]=PKW(P0,8), pw1[1]=PKW(P0,10), pw1); \
    VRD(5); SBAR(); GAPA(C1=__builtin_amdgcn_mfma_f32_32x32x16_bf16(kf[3],qr[1],C1,0,0,0),   P0[14],P0[15],P1[0],P1[1],   pw1[2]=PKW(P0,12),pw1[3]=PKW(P0,14), pw1); \
    VRD(2); SBAR(); GAPA(C0=__builtin_amdgcn_mfma_f32_32x32x16_bf16(kf[4],qr[2],C0,0,0,0),   P1[2],P1[3],P1[4],P1[5],     pw2[0]=PKW(P1,0), pw2[1]=PKW(P1,2), pw2); \
    VRD(6); SBAR(); GAPA(C1=__builtin_amdgcn_mfma_f32_32x32x16_bf16(kf[5],qr[2],C1,0,0,0),   P1[6],P1[7],P1[8],P1[9],     pw2[2]=PKW(P1,4), pw2[3]=PKW(P1,6), pw2); \
    VRD(3); SBAR(); GAPA(C0=__builtin_amdgcn_mfma_f32_32x32x16_bf16(kf[6],qr[3],C0,0,0,0),   P1[10],P1[11],P1[12],P1[13], pw3[0]=PKW(P1,8), pw3[1]=PKW(P1,10), pw3); \
    VRD(7); SBAR(); GAPA(C1=__builtin_amdgcn_mfma_f32_32x32x16_bf16(kf[7],qr[3],C1,0,0,0),   P1[14],P1[15],0.f,0.f,       pw3[2]=PKW(P1,12),pw3[3]=PKW(P1,14), pw3); \
    l_reg+=sacc; \
    if(GK){DMA_K((t)+3,sl_cur);} if(GV){DMA_V((t)+1,sl_next);} \
    CMASK(C0,C1,t); \
    SBAR(); \
    GAPB(o[0]=__builtin_amdgcn_mfma_f32_32x32x16_bf16(PAF(0),VFR(0),o[0],0,0,0), C0,0); \
    GAPB(o[1]=__builtin_amdgcn_mfma_f32_32x32x16_bf16(PAF(0),VFR(4),o[1],0,0,0), C0,4); \
    KRD(GL,0); GAPB(o[0]=__builtin_amdgcn_mfma_f32_32x32x16_bf16(PAF(1),VFR(1),o[0],0,0,0), C0,8); \
    KRD(GL,1); GAPB(o[1]=__builtin_amdgcn_mfma_f32_32x32x16_bf16(PAF(1),VFR(5),o[1],0,0,0), C0,12); \
    KRD(GL,2); GAPB(o[0]=__builtin_amdgcn_mfma_f32_32x32x16_bf16(PAF(2),VFR(2),o[0],0,0,0), C1,0); \
    KRD(GL,3); GAPB(o[1]=__builtin_amdgcn_mfma_f32_32x32x16_bf16(PAF(2),VFR(6),o[1],0,0,0), C1,4); \
    GAPB(o[0]=__builtin_amdgcn_mfma_f32_32x32x16_bf16(PAF(3),VFR(3),o[0],0,0,0), C1,8); \
    GAPB(o[1]=__builtin_amdgcn_mfma_f32_32x32x16_bf16(PAF(3),VFR(7),o[1],0,0,0), C1,12); \
    }while(0)
  int t=1;
  #undef CMASK
  #define CMASK(P0,P1,t) do{}while(0)
  for(;t+5<NT;t+=2){
    STEP(pB0,pB1,pA0,pA1,t,true,true,true);     WAIT_BAR(2); RESC(); ROT();
    STEP(pA0,pA1,pB0,pB1,t+1,true,true,true);   WAIT_BAR(2); RESC(); ROT();
  }
  #undef CMASK
  #define CMASK(P0,P1,t) do{int jb_=(t)-(NT-4); if(jb_>=0)cmask(P0,P1,jb_,qrel,hi);}while(0)
  #define ENDW(tt) do{ if((tt)+3<NT){WAIT_BAR(2);} else if((tt)+2<NT){WAIT_BAR(1);} else {WAIT_BAR(0);} }while(0)
  for(;t+1<NT;t+=2){
    STEP(pB0,pB1,pA0,pA1,t,(t+3<NT),(t+1<NT),(t+1<NT));       ENDW(t);   RESC(); ROT();
    STEP(pA0,pA1,pB0,pB1,t+1,(t+4<NT),(t+2<NT),(t+2<NT));     ENDW(t+1); RESC(); ROT();
  }
  STEP(pB0,pB1,pA0,pA1,NT-1,false,false,false); RESC();
  { float sacc=pB0[0]+pB0[1]; _Pragma("unroll") for(int r=2;r<16;++r)sacc+=pB0[r]; _Pragma("unroll") for(int r=0;r<16;++r)sacc+=pB1[r]; l_reg+=sacc;
    pw0=(u32x4){PKW(pB0,0),PKW(pB0,2),PKW(pB0,4),PKW(pB0,6)};pw1=(u32x4){PKW(pB0,8),PKW(pB0,10),PKW(pB0,12),PKW(pB0,14)};pw2=(u32x4){PKW(pB1,0),PKW(pB1,2),PKW(pB1,4),PKW(pB1,6)};pw3=(u32x4){PKW(pB1,8),PKW(pB1,10),PKW(pB1,12),PKW(pB1,14)};
    SBAR(); pv(o,vb0+sl_cur,PAF(0),PAF(1),PAF(2),PAF(3)); }
  #undef PKW
  #undef PAF
  #undef VFR
  #undef PIN
  #undef MX3
  #undef GAPA
  #undef GAPB
  #undef EX
  #undef VRD
  #undef KRD
  #undef STEP
  #undef ENDW
  {auto rr=__builtin_amdgcn_permlane32_swap(__float_as_uint(l_reg),__float_as_uint(l_reg),false,false);l_reg=__uint_as_float(rr[0])+__uint_as_float(rr[1]);}
  if(hi==0)wsf[32+r32]=l_reg;asm volatile("s_waitcnt lgkmcnt(0)":::"memory");
  float rli[16];
  #pragma unroll
  for(int r=0;r<16;++r)rli[r]=__builtin_amdgcn_rcpf(wsf[32+crow(r,hi)]);
  bf16*Ow=O+(rowbase+q0+wid*QBLK)*OPITCH+h*D;
  { bf16*stg=(bf16*)(shm+LDS_OST)+wid*2048;
    #pragma unroll
    for(int r=0;r<16;++r){const int orow=crow(r,hi);
      #pragma unroll
      for(int d0=0;d0<2;++d0)stg[orow*64+d0*32+r32]=__float2bfloat16(o[d0][r]*rli[r]);}
    asm volatile("s_waitcnt lgkmcnt(0)":::"memory");
    #pragma unroll
    for(int i=0;i<4;++i){const int row=i*8+(lane>>3),ch=lane&7; const u32x4 v=*(const u32x4*)(stg+row*64+ch*8); ATTN_STORE16(Ow+(long)row*OPITCH+ch*8,v);
      float q=0.f;
      #pragma unroll
      for(int e=0;e<4;++e){const float lo=__uint_as_float(v[e]<<16),hi_=__uint_as_float(v[e]&0xffff0000u);q+=lo*lo+hi_*hi_;}
      q+=__shfl_xor(q,1);q+=__shfl_xor(q,2);q+=__shfl_xor(q,4);
      if(ch==0)unsafeAtomicAdd(SS+(rowbase+q0+wid*QBLK+row),q);} }
  asm volatile("s_waitcnt lgkmcnt(0)\n\ts_barrier":::"memory");
  #undef DMA_K
  #undef DMA_V
  #undef CMASK
  #undef RESC
  #undef ROT
}
constexpr int ATTN_LDS_BYTES=LDS_BYTES;
constexpr int F2_OFF=90112, SCAN_OFF=F2_OFF+SEQ*4;
constexpr float LOG2E=1.4426950408889634f;
template<int THRL=8> __device__ __forceinline__ void attn_phase(char*lds,const bf16*Hq,const bf16*Hk,const bf16*Hv,bf16*O,const float*logf,int vcu,const float REF,float*SS){
  const int bh=vcu>>1,s=vcu&1,b=bh/NHEAD,h=bh%NHEAD; int tid_=threadIdx.x; asm volatile("":"+v"(tid_)); const int tid=tid_,lane=tid&63,wid=tid>>6;
  typedef __attribute__((address_space(3))) float lfloat;
  lfloat*F2=(lfloat*)(__attribute__((address_space(3))) char*)lds+F2_OFF/4; lfloat*SC=(lfloat*)(__attribute__((address_space(3))) char*)lds+SCAN_OFF/4;
  { const float*src=logf+((long)b*SEQ+tid*4)*NHEAD+h;
    float v0=src[0],v1=src[NHEAD],v2=src[2*NHEAD],v3=src[3*NHEAD];
    v1+=v0;v2+=v1;v3+=v2; float x=v3;
    #pragma unroll
    for(int d=1;d<64;d<<=1){const float t=__shfl_up(x,d);if(lane>=d)x+=t;}
    if(lane==63)SC[wid]=x;
    __syncthreads();
    float off=x-v3;
    #pragma unroll
    for(int w=0;w<NW;++w){const float pw=SC[w];if(w<wid)off+=pw;}
    F2[tid*4+0]=(off+v0)*LOG2E;F2[tid*4+1]=(off+v1)*LOG2E;F2[tid*4+2]=(off+v2)*LOG2E;F2[tid*4+3]=(off+v3)*LOG2E;
    __syncthreads(); }
  #pragma unroll 1
  for(int i=0;i<4;++i){ const int qb=(i>>1)*4+((i&1)?3-s:s); attn_unit<THRL>(b,h,qb,Hq,Hk,Hv,O,lds,F2,REF,SS); }
}
#undef SBAR
#undef WAIT_BAR
}
#include <hip/hip_cooperative_groups.h>
namespace cg = cooperative_groups;
constexpr int NWAVES = 8;
#ifndef REP_MASK
#define REP_MASK 0
#endif
constexpr int REP_MASK_ = REP_MASK;
#define REPS(k) (((REP_MASK_ >> (k)) & 1) + 1)
#define GSYNC() do { xcd_barrier(bar); if (REP_MASK_ & 256) xcd_barrier(bar); } while (0)
#define LSYNC() do { if (local_ok) xcc_barrier_local(bar); else xcd_barrier(bar); } while (0)
constexpr int BATCH = 16, SEQ = 2048, DM = 1024, M = BATCH * SEQ, FF = 2816, NGU = 2 * FF, NIN = 2048, INC = 2056, NH = 8;
constexpr size_t MiB = 1u << 20;
constexpr size_t WS_CTL = 0;
constexpr size_t WS_TAB = 512 * 1024;
constexpr size_t WS_STAT = 1 * MiB;
constexpr size_t WS_LOGF = 3 * MiB;
constexpr size_t WS_WGU1 = 4 * MiB, WS_WD1 = 15 * MiB, WS_WIN = 21 * MiB, WS_WOUT = 25 * MiB, WS_WGU2 = 27 * MiB, WS_WD2 = 38 * MiB, WS_WPOOL = 44 * MiB;
constexpr size_t WS_WF = 45 * MiB;
constexpr size_t WS_ASS = 46 * MiB;
constexpr size_t WS_XB = 48 * MiB;
constexpr size_t WS_ACT = 112 * MiB;
constexpr size_t WS_H = 352 * MiB;
constexpr size_t WS_Y = 288 * MiB;
constexpr size_t WS_END = 480 * MiB;
constexpr int RING_BYTES = 131072, LDS_BYTES = 147456;

#define GAS __attribute__((address_space(1)))
#define LAS __attribute__((address_space(3)))
typedef unsigned short u16;
typedef unsigned v4u __attribute__((ext_vector_type(4)));
typedef unsigned v2u __attribute__((ext_vector_type(2)));
typedef float f32x4 __attribute__((ext_vector_type(4)));
typedef short bf16x8 __attribute__((ext_vector_type(8)));
#define LDS_WAIT() asm volatile("s_waitcnt lgkmcnt(0)" ::: "memory")
__device__ __forceinline__ unsigned pk2(float lo, float hi) { return pg8::cvt_pk_bf16(lo, hi); }
__device__ __forceinline__ float wave_sum(float v) {
#pragma unroll
    for (int o = 1; o < 64; o <<= 1) v += __shfl_xor(v, o);
    return v;
}
__device__ __forceinline__ float bflo(unsigned w) { return __uint_as_float(w << 16); }
__device__ __forceinline__ float bfhi(unsigned w) { return __uint_as_float(w & 0xffff0000u); }

#define RLX_AGENT __ATOMIC_RELAXED, __HIP_MEMORY_SCOPE_AGENT
#define XB_TMO      128
#define XB_XCNT(j)  (256  + 64 * (j))
#define XB_XSUB(j)  (1280 + 64 * (j))
#define XB_XGEN(j)  (2304 + 64 * (j))
#define XB_TOP      3328
#define XB_TOPGEN   3392
#define XCD_BAR_WORDS 3456
#define XB_SPIN_CAP (1u << 18)

__device__ __forceinline__ unsigned xb_ld(unsigned* p)              { return __hip_atomic_load(p, __ATOMIC_RELAXED, __HIP_MEMORY_SCOPE_AGENT); }
__device__ __forceinline__ unsigned xb_add(unsigned* p, unsigned v) { return __hip_atomic_fetch_add(p, v, __ATOMIC_RELAXED, __HIP_MEMORY_SCOPE_AGENT); }
__device__ __forceinline__ unsigned xb_xcc_id() { return (unsigned)__builtin_amdgcn_s_getreg((3 << 11) | 20) & 0xFu; }
#define XB_SPIN(cond, bar) do { unsigned _sp = 0; while (cond) { __builtin_amdgcn_s_sleep(1); \
    if ((++_sp & 255u) == 0u) { if (xb_ld(&(bar)[XB_TMO])) break; if (_sp > XB_SPIN_CAP) { atomicAdd(&(bar)[XB_TMO], 1u); break; } } } } while (0)

struct XcdBarrier {
    unsigned* bar; unsigned x; unsigned rank;
    volatile LAS unsigned* st;
};

__device__ __forceinline__ XcdBarrier xcd_barrier_post(unsigned* bar, volatile LAS unsigned* st) {
    XcdBarrier b; b.bar = bar; b.x = xb_xcc_id(); b.st = st;
    b.rank = 0u; if (threadIdx.x == 0) b.rank = xb_add(&bar[XB_XCNT(b.x)], 1u);
    return b;
}
__device__ __forceinline__ void xcd_barrier_complete(unsigned* bar, unsigned x, unsigned& nloc, unsigned& nx) {
    const unsigned G = gridDim.x * gridDim.y * gridDim.z;
    unsigned sum, cnt, mine, sp = 0u;
    for (;;) {
        sum = 0u; cnt = 0u; mine = 0u;
#pragma unroll
        for (unsigned j = 0; j < 16; ++j) { const unsigned c = xb_ld(&bar[XB_XCNT(j)]); sum += c; cnt += (c > 0u) ? 1u : 0u; mine = (j == x) ? c : mine; }
        if (sum == G) break;
        __builtin_amdgcn_s_sleep(1);
        if ((++sp & 255u) == 0u) { if (xb_ld(&bar[XB_TMO])) break; if (sp > XB_SPIN_CAP) { atomicAdd(&bar[XB_TMO], 1u); break; } }
    }
    nloc = mine > 0u ? mine : 1u; nx = cnt > 0u ? cnt : 1u;
}

__device__ __forceinline__ void xcd_barrier(const XcdBarrier& b) {
    asm volatile("s_waitcnt vmcnt(0)" ::: "memory");
    __syncthreads();
    if (threadIdx.x == 0) {
        unsigned* bar = b.bar;
        __builtin_amdgcn_s_waitcnt(0);
        unsigned nloc = b.st[0], nx = b.st[1];
        if (nloc == 0u) { xcd_barrier_complete(bar, b.x, nloc, nx); b.st[0] = nloc; b.st[1] = nx; }
        const unsigned old = xb_add(&bar[XB_XSUB(b.x)], 1u);
        const unsigned gen = old / nloc;
        if (old + 1u == (gen + 1u) * nloc) {
            __builtin_amdgcn_fence(__ATOMIC_RELEASE, "agent");
            asm volatile("s_waitcnt vmcnt(0)" ::: "memory");
            const unsigned og = xb_add(&bar[XB_TOP], 1u);
            const unsigned tg = og / nx;
            if (og + 1u == (tg + 1u) * nx) xb_add(&bar[XB_TOPGEN], 1u);
            else XB_SPIN(xb_ld(&bar[XB_TOPGEN]) == tg, bar);
            __builtin_amdgcn_fence(__ATOMIC_ACQUIRE, "agent");
            xb_add(&bar[XB_XGEN(b.x)], 1u);
            asm volatile("s_waitcnt vmcnt(0)" ::: "memory");
        } else {
            __builtin_amdgcn_fence(__ATOMIC_ACQUIRE, "agent");
            XB_SPIN(xb_ld(&bar[XB_XGEN(b.x)]) == gen, bar);
            asm volatile("s_waitcnt vmcnt(0)" ::: "memory");
        }
    }
    __syncthreads();
}

#define XB_LSUB(j)  (4096 + 64 * (j))
#define XB_LGEN(j)  (5120 + 64 * (j))
__device__ __forceinline__ void xcc_barrier_local(const XcdBarrier& b) {
    asm volatile("s_waitcnt vmcnt(0)" ::: "memory");
    __syncthreads();
    if (threadIdx.x == 0) {
        unsigned* bar = b.bar; const unsigned nloc = b.st[0];
        __builtin_amdgcn_fence(__ATOMIC_ACQUIRE, "agent");
        const unsigned old = xb_add(&bar[XB_LSUB(b.x)], 1u), gen = old / nloc;
        if (old + 1u == (gen + 1u) * nloc) xb_add(&bar[XB_LGEN(b.x)], 1u);
        else XB_SPIN(xb_ld(&bar[XB_LGEN(b.x)]) == gen, bar);
        asm volatile("s_waitcnt vmcnt(0)" ::: "memory");
    }
    __syncthreads();
}

struct Args { const float* in[19]; float* out; unsigned char* ws; };

__device__ __forceinline__ void xpose_item(const float* W, int ldw, int k0, int n0, const float* gain, u16* WT, int K, int drow, LAS float* scr, int lane) {
#pragma unroll
    for (int i = 0; i < 32; ++i) { const int kk = 2 * i + (lane >> 5); float v = __builtin_nontemporal_load(W + (size_t)(k0 + kk) * ldw + n0 + (lane & 31));     if (gain) v *= gain[k0 + kk]; scr[kk * 33 + (lane & 31)] = v; }
    LDS_WAIT(); asm volatile("" ::: "memory");
    const int c = lane & 7;
#pragma unroll
    for (int j = 0; j < 4; ++j) { const int n = (lane >> 3) + 8 * j; const LAS float* s = scr + (8 * c) * 33 + n;
        v4u o; o.x = pk2(s[0 * 33], s[1 * 33]); o.y = pk2(s[2 * 33], s[3 * 33]); o.z = pk2(s[4 * 33], s[5 * 33]); o.w = pk2(s[6 * 33], s[7 * 33]);
        *(v4u*)(WT + (size_t)(drow + n) * K + k0 + 8 * c) = o; }
    LDS_WAIT(); asm volatile("" ::: "memory");
}
template <int MODE> __device__ __forceinline__ void xpose_mat(const float* W, int ldw, int K, int N, const float* gain, u16* WT, LAS float* scr, int lane, int r) {
    const int nblk = N / 32, kb = r / nblk, nb = r % nblk, k0 = 64 * kb, n0 = 32 * nb; int drow = n0;
    if (MODE == 1 || MODE == 2) drow = 256 * (n0 / 128) + (n0 % 128) + (MODE == 2 ? 128 : 0);
    if (MODE == 3 && n0 < 512) return;
    if (MODE == 3 && n0 >= 512 && n0 < 1536) drow = 256 * (n0 / 256) + 128 * ((n0 % 64) / 32) + 32 * ((n0 % 256) / 64);
    xpose_item(W, ldw, k0, n0, gain, WT, K, drow, scr, lane);
}

template <int MODE> __device__ __forceinline__ void xpose8(const float* W, int ldw, int K, int ntiles, int ncol0, const float* gain, u16* WT, int ln, int r) {
    const int per = 8 * ntiles, kb = r / per, rem = r % per, nt = rem >> 3, k0 = kb * 64 + (rem & 7) * 8, n = ncol0 + nt * 256 + 4 * ln;
    f32x4 v[8];
#pragma unroll
    for (int i = 0; i < 8; ++i) v[i] = __builtin_nontemporal_load((const f32x4*)(W + (size_t)(k0 + i) * ldw + n));
    if (gain) {
#pragma unroll
        for (int i = 0; i < 8; ++i) v[i] = v[i] * gain[k0 + i]; }
    int drow = n;
    if (MODE == 1 || MODE == 2) drow = 256 * (n / 128) + (n % 128) + (MODE == 2 ? 128 : 0);
    if (MODE == 3 && n >= 512 && n < 1536) drow = 256 * (n / 256) + 128 * ((n % 64) / 32) + 32 * ((n % 256) / 64) + (n % 32);
#pragma unroll
    for (int j = 0; j < 4; ++j) { v4u o; o.x = pk2(v[0][j], v[1][j]); o.y = pk2(v[2][j], v[3][j]); o.z = pk2(v[4][j], v[5][j]); o.w = pk2(v[6][j], v[7][j]);
        *(v4u*)(WT + (size_t)(drow + j) * K + k0) = o; }
}

__global__ void __launch_bounds__(NWAVES * 64, 2) hymba_fwd(Args args) {
    extern __shared__ __attribute__((aligned(16))) unsigned char lds[];
    cg::grid_group grid = cg::this_grid();
    LAS unsigned char* ldsl = (LAS unsigned char*)lds;
    const int tid = threadIdx.x, lane = tid & 63, wave = __builtin_amdgcn_readfirstlane(tid >> 6);
    const int G = gridDim.x; int bx = blockIdx.x; int vcu = (G % 8 == 0) ? (bx % 8) * (G / 8) + bx / 8 : bx;
    unsigned char* ws = args.ws;
    const float* x = args.in[0]; float* out = args.out;
    float* STAT = (float*)(ws + WS_STAT); float* STAT1 = STAT + M; float* STAT2 = STAT + 2 * M; float* LOGF = (float*)(ws + WS_LOGF); float* ASS = (float*)(ws + WS_ASS);
    u16* WGU1 = (u16*)(ws + WS_WGU1); u16* WD1 = (u16*)(ws + WS_WD1); u16* WIN = (u16*)(ws + WS_WIN); u16* WOUT = (u16*)(ws + WS_WOUT);
    u16* WGU2 = (u16*)(ws + WS_WGU2); u16* WD2 = (u16*)(ws + WS_WD2); u16* WF = (u16*)(ws + WS_WF);
    u16* XB = (u16*)(ws + WS_XB); u16* ACT = (u16*)(ws + WS_ACT); u16* H = (u16*)(ws + WS_H); u16* Y = (u16*)(ws + WS_Y);
    int gw = vcu * NWAVES + wave; const int NGW = G * NWAVES;

    if (tid < 64) ((LAS unsigned*)(ldsl + RING_BYTES))[tid] = 0u;
    if (ws == nullptr) grid.sync();
    XcdBarrier bar = xcd_barrier_post((unsigned*)(ws + WS_CTL) + 64, (volatile LAS unsigned*)(ldsl + RING_BYTES + 64));
    if (bx == 0 && tid == 0) { unsigned long long* tab = (unsigned long long*)(ws + WS_TAB);
        tab[0] = (unsigned long long)args.in[4]; tab[1] = (unsigned long long)args.in[6]; tab[2] = (unsigned long long)args.in[14]; tab[3] = (unsigned long long)args.in[16]; tab[4] = (unsigned long long)args.in[17]; tab[5] = (unsigned long long)args.in[18];
        tab[6] = (unsigned long long)args.in[5]; tab[7] = (unsigned long long)args.in[15];
        tab[8] = (unsigned long long)WD1; tab[9] = (unsigned long long)WIN; tab[10] = (unsigned long long)WOUT; tab[11] = (unsigned long long)WGU2; tab[12] = (unsigned long long)WD2; tab[13] = (unsigned long long)(args.in[13] - 512); }
    for (int rep_ = 0; rep_ < REPS(0); ++rep_) {
        LAS float* scr = (LAS float*)(ldsl + wave * 16384);
        constexpr int I_P = 4 * 16 * 4;
        const int gw0 = wave * G + vcu;
        for (int rep2_ = 0; rep2_ < REPS(9); ++rep2_) {
        for (int it = gw0; it < I_P + 16; it += NGW) {
            int r = it; int ln = lane; asm volatile("" : "+v"(ln));
            if (r < I_P) {
                const int g = r >> 6, k0 = ((r >> 2) & 15) * 64, d0 = (r & 3) * 32;
                const float* P = args.in[8] + (size_t)g * 16384 + d0;
#pragma unroll
                for (int i = 0; i < 16; ++i) { const int c = 8 * i + (ln >> 3), dd = (ln & 7) * 4; *(LAS f32x4*)(scr + c * 32 + dd) = *(const f32x4*)(P + (size_t)c * 128 + dd); }
                LDS_WAIT(); asm volatile("" ::: "memory");
                const float* wrow = args.in[6] + (size_t)(k0 + ln) * INC + 128 * g;
                float a[32];
#pragma unroll
                for (int d = 0; d < 32; ++d) a[d] = 0.f;
                f32x4 wv[32];
#pragma unroll
                for (int c4 = 0; c4 < 32; ++c4) wv[c4] = *(const f32x4*)(wrow + 4 * c4);
#pragma unroll
                for (int c4 = 0; c4 < 32; ++c4) { const f32x4 w4 = wv[c4];
#pragma unroll
                    for (int ci = 0; ci < 4; ++ci)
#pragma unroll
                        for (int d4 = 0; d4 < 8; ++d4) { const f32x4 p4 = *(const LAS f32x4*)(scr + (4 * c4 + ci) * 32 + 4 * d4);
                            a[4 * d4 + 0] += w4[ci] * p4[0]; a[4 * d4 + 1] += w4[ci] * p4[1]; a[4 * d4 + 2] += w4[ci] * p4[2]; a[4 * d4 + 3] += w4[ci] * p4[3]; } }
                const float gk = args.in[5][k0 + ln];
#pragma unroll
                for (int d = 0; d < 32; ++d) WIN[(size_t)(128 * g + d0 + d) * DM + k0 + ln] = (u16)(pk2(a[d] * gk, 0.f) & 0xffffu);
                LDS_WAIT(); asm volatile("" ::: "memory");
                continue; } r -= I_P;
            { const int k = 64 * r + ln; const float gk = args.in[5][k]; const f32x4 w0 = *(const f32x4*)(args.in[6] + (size_t)k * INC + NIN), w1 = *(const f32x4*)(args.in[6] + (size_t)k * INC + NIN + 4);
#pragma unroll
              for (int c = 0; c < 8; ++c) { WF[c * DM + k] = (u16)(pk2((c < 4 ? w0[c & 3] : w1[c & 3]) * gk, 0.f) & 0xffffu); WF[(8 + c) * DM + k] = 0; } }
        }
        constexpr int T_GU = (DM / 8) * (FF / 256);
        for (int it = gw; it < 2 * T_GU; it += NGW) {
            int r = it; int ln = lane; asm volatile("" : "+v"(ln));
            if (r < T_GU) { xpose8<1>(args.in[2], FF, DM, FF / 256, 0, args.in[1], WGU1, ln, r); continue; } r -= T_GU;
            xpose8<2>(args.in[3], FF, DM, FF / 256, 0, args.in[1], WGU1, ln, r);
        }
        }
        for (int rep2_ = 0; rep2_ < REPS(10); ++rep2_)
        for (int m0 = gw0 * 4; m0 < M; m0 += NGW * 4) {
            f32x4 v[4][4]; float sq[4];
#pragma unroll
            for (int r = 0; r < 4; ++r) { const f32x4* xr = (const f32x4*)(x + (size_t)(m0 + r) * DM) + lane;
#pragma unroll
                for (int j = 0; j < 4; ++j) v[r][j] = __builtin_nontemporal_load(xr + 64 * j); }
#pragma unroll
            for (int r = 0; r < 4; ++r) { float s_ = 0.f;
#pragma unroll
                for (int j = 0; j < 4; ++j) s_ += (v[r][j][0] * v[r][j][0] + v[r][j][1] * v[r][j][1]) + (v[r][j][2] * v[r][j][2] + v[r][j][3] * v[r][j][3]);
                sq[r] = wave_sum(s_); }
#pragma unroll
            for (int r = 0; r < 4; ++r) { v2u* o8 = (v2u*)(XB + (size_t)(m0 + r) * DM) + lane;
#pragma unroll
                for (int j = 0; j < 4; ++j) { v2u w; w.x = pk2(v[r][j][0], v[r][j][1]); w.y = pk2(v[r][j][2], v[r][j][3]); o8[64 * j] = w; } }
            if (lane < 4) { const float s01 = (lane & 1) ? sq[1] : sq[0], s23 = (lane & 1) ? sq[3] : sq[2]; STAT[m0 + lane] = (lane & 2) ? s23 : s01; STAT1[m0 + lane] = 0.f; STAT2[m0 + lane] = 0.f; ASS[m0 + lane] = 0.f; }
        }
    }
    GSYNC();
    bool local_ok;
    { volatile LAS unsigned* ctlw = (volatile LAS unsigned*)(ldsl + RING_BYTES);
      if (tid == 0) { unsigned ok = (G % 8 == 0 && bar.x < 8u) ? 1u : 0u;
#pragma unroll
          for (unsigned j = 0; j < 16; ++j) { const unsigned c = xb_ld(&bar.bar[XB_XCNT(j)]); if (c != (j < 8u ? (unsigned)(G / 8) : 0u)) ok = 0u; }
          ctlw[32] = ok; ctlw[33] = bar.rank; }
      __syncthreads();
      local_ok = ctlw[32] != 0u && (REP_MASK_ & 1024) == 0;
      if (local_ok) { const int rank = (int)ctlw[33], xcc = (int)bar.x; vcu = xcc * (G / 8) + rank; bx = rank * 8 + xcc; gw = vcu * NWAVES + wave; } }

    for (int rep_ = 0; rep_ < REPS(1); ++rep_)
    { pg8::Gemm g{XB, WGU1, M, NGU, DM}; pg8::StaticOrder S; S.init(M, NGU, G, bx); pg8::SideXpose sx{(const unsigned long long*)(ws + WS_TAB)};
      pg8::EpiGU<true> E{ACT, FF, STAT, sx};
      pg8::gemm_phase<pg8::EpiGU<true>, pg8::StaticOrder, true, true>(ldsl, g, S, E); }
    GSYNC();
    for (int rep_ = 0; rep_ < REPS(2); ++rep_)
    { pg8::Gemm g{ACT, WD1, M, DM, FF}; pg8::StaticOrder S; S.init(M, DM, G, bx); pg8::EpiRes<false> E{nullptr, XB, STAT1, 0.5f};
      pg8::gemm_phase<pg8::EpiRes<false>, pg8::StaticOrder, true, true>(ldsl, g, S, E); }
    LSYNC();
    for (int rep_ = 0; rep_ < REPS(3); ++rep_)
    { pg8::Gemm g{XB, WIN, M, NIN, DM}; pg8::StaticOrder S; S.init(M, NIN, G, bx); pg8::EpiIn E{H, STAT1, args.in[10], args.in[11], attn_body::C2};
      pg8::gemm_phase<pg8::EpiIn, pg8::StaticOrder, true, true>(ldsl, g, S, E); }
    for (int rep_ = 0; rep_ < REPS(5); ++rep_)
    {
        const int fr = lane & 15, fq = lane >> 4; const int row = vcu * 128 + wave * 16 + fr;
        const u16* ap = XB + (size_t)row * DM + 8 * fq; const u16* bp = WF + (size_t)fr * DM + 8 * fq;
        f32x4 c = (f32x4){0.f, 0.f, 0.f, 0.f};
#pragma unroll 16
        for (int ks = 0; ks < 32; ++ks) c = __builtin_amdgcn_mfma_f32_16x16x32_bf16(*(const bf16x8*)(bp + 32 * ks), *(const bf16x8*)(ap + 32 * ks), c, 0, 0, 0);
        if (fq < 2) { const float rs = pg8::row_rs(STAT1, row); const f32x4 bf = *(const f32x4*)(args.in[7] + 4 * fq); f32x4 o;
#pragma unroll
            for (int i = 0; i < 4; ++i) { const float z = c[i] * rs + bf[i]; o[i] = (z >= 0.f) ? -log1pf(expf(-z)) : (z - log1pf(expf(z))); }
            *(f32x4*)(LOGF + (size_t)row * NH + 4 * fq) = o; }
    }
    LSYNC();
    float aref;
    { float mq = fabsf(args.in[10][lane]), mk = fabsf(args.in[11][lane]);
#pragma unroll
      for (int o_ = 1; o_ < 64; o_ <<= 1) { mq = fmaxf(mq, __shfl_xor(mq, o_)); mk = fmaxf(mk, __shfl_xor(mk, o_)); }
      aref = attn_body::C2 * 64.0f * mq * mk * 1.02f; }
    for (int rep_ = 0; rep_ < REPS(4); ++rep_)
    attn_body::attn_phase<8>((char*)lds, (const attn_body::bf16*)(H + 512), (const attn_body::bf16*)(H + 1024), (const attn_body::bf16*)(H + 1536), (attn_body::bf16*)(Y + 512), LOGF, vcu, aref, ASS);
    for (int rep_ = 0; rep_ < REPS(6); ++rep_)
    {
        const float* pscale = args.in[9]; const float* pgain = args.in[12];
        const int ch = lane * 8, w = 2 << (lane >> 4);
        const f32x4 ps0 = *(const f32x4*)(pscale + ch), ps1 = *(const f32x4*)(pscale + ch + 4), pg0 = *(const f32x4*)(pgain + ch), pg1 = *(const f32x4*)(pgain + ch + 4);
        for (int unit = gw; unit < M / 16; unit += NGW) {
            const int r0 = unit * 16, t0 = r0 % SEQ; const u16* zp = H + (size_t)r0 * 2048 + ch;
            v4u zr[16], mr[16];
#pragma unroll
            for (int i = 0; i < 16; ++i) { zr[i] = *(const v4u*)(zp + (size_t)i * 2048); mr[i] = (t0 + i >= w) ? *(const v4u*)(zp + (size_t)(i - w) * 2048) : (v4u){0u, 0u, 0u, 0u}; }
            float S[8];
#pragma unroll
            for (int e = 0; e < 8; ++e) S[e] = 0.f;
#pragma unroll
            for (int j = 1; j <= 16; ++j) { if (j <= w && j <= t0) { const v4u c = *(const v4u*)(zp - (size_t)j * 2048);
                    S[0] += bflo(c.x); S[1] += bfhi(c.x); S[2] += bflo(c.y); S[3] += bfhi(c.y); S[4] += bflo(c.z); S[5] += bfhi(c.z); S[6] += bflo(c.w); S[7] += bfhi(c.w); } }
#pragma unroll
            for (int hh = 0; hh < 2; ++hh) {
                float y[8][8], q[8];
#pragma unroll
                for (int ii = 0; ii < 8; ++ii) { const int i = 8 * hh + ii, t = t0 + i; const v4u c = zr[i]; float z[8];
                    z[0] = bflo(c.x); z[1] = bfhi(c.x); z[2] = bflo(c.y); z[3] = bfhi(c.y); z[4] = bflo(c.z); z[5] = bfhi(c.z); z[6] = bflo(c.w); z[7] = bfhi(c.w);
                    { const v4u d = mr[i];
                        S[0] += z[0] - bflo(d.x); S[1] += z[1] - bfhi(d.x); S[2] += z[2] - bflo(d.y); S[3] += z[3] - bfhi(d.y); S[4] += z[4] - bflo(d.z); S[5] += z[5] - bfhi(d.z); S[6] += z[6] - bflo(d.w); S[7] += z[7] - bfhi(d.w); }
                    const float inv = __builtin_amdgcn_rcpf((float)((t + 1 < w) ? (t + 1) : w));
                    float qq = 0.f;
#pragma unroll
                    for (int e = 0; e < 8; ++e) { y[ii][e] = (S[e] * inv - z[e]) * (e < 4 ? ps0[e & 3] : ps1[e & 3]); qq += y[ii][e] * y[ii][e]; }
                    q[ii] = qq; }
#define RS_STEP(n, bit) _Pragma("unroll") for (int k = 0; k < (n) / 2; ++k) { const bool up = (lane & (bit)) != 0; const float send = up ? q[k] : q[k + (n) / 2]; const float keep = up ? q[k + (n) / 2] : q[k]; q[k] = keep + __shfl_xor(send, (bit)); }
                RS_STEP(8, 32) RS_STEP(4, 16) RS_STEP(2, 8)
#undef RS_STEP
                float tot = q[0]; tot += __shfl_xor(tot, 4); tot += __shfl_xor(tot, 2); tot += __shfl_xor(tot, 1);
                const float rsl = __builtin_amdgcn_rsqf(tot * (1.0f / 512.0f) + pg8::RMS_EPS);
#pragma unroll
                for (int ii = 0; ii < 8; ++ii) { const float rs = __int_as_float(__builtin_amdgcn_readlane(__float_as_int(rsl), ((ii & 4) ? 32 : 0) + ((ii & 2) ? 16 : 0) + ((ii & 1) ? 8 : 0)));
                    v4u o; o.x = pk2(y[ii][0] * rs * pg0[0], y[ii][1] * rs * pg0[1]); o.y = pk2(y[ii][2] * rs * pg0[2], y[ii][3] * rs * pg0[3]); o.z = pk2(y[ii][4] * rs * pg1[0], y[ii][5] * rs * pg1[1]); o.w = pk2(y[ii][6] * rs * pg1[2], y[ii][7] * rs * pg1[3]);
                    *(v4u*)(Y + (size_t)(r0 + 8 * hh + ii) * 1024 + ch) = o; }
            }
        }
    }
    LSYNC();
    { pg8::Gemm g{Y, WOUT, M, DM, DM}; pg8::StaticOrder S; S.init(M, DM, G, bx); pg8::EpiOut E{XB, STAT2, ASS};
      pg8::gemm_phase<pg8::EpiOut, pg8::StaticOrder, true, true>(ldsl, g, S, E); }
    LSYNC();
    { pg8::Gemm g{XB, WGU2, M, NGU, DM}; pg8::StaticOrder S; S.init(M, NGU, G, bx); pg8::EpiGU<false> E{ACT, FF, STAT2, pg8::SideXpose{}};
      pg8::gemm_phase<pg8::EpiGU<false>, pg8::StaticOrder, true, true>(ldsl, g, S, E); }
    LSYNC();
    for (int rep_ = 0; rep_ < REPS(7); ++rep_)
    { pg8::Gemm g{ACT, WD2, M, DM, FF}; pg8::StaticOrder S; S.init(M, DM, G, bx); pg8::EpiRes<true> E{out, XB, nullptr, 0.5f};
      pg8::gemm_phase<pg8::EpiRes<true>, pg8::StaticOrder, true, true>(ldsl, g, S, E); }
}

extern "C" void kernel_launch(void* const* d_in, const int* in_sizes, int n_in, void* d_out, int out_size, void* d_ws, size_t ws_size, hipStream_t stream) {
    static int grid = 0;
    if (grid == 0) {
        if (n_in != 19 || in_sizes[0] != M * DM || out_size != M * DM || ws_size < WS_END) { fprintf(stderr, "kernel_launch: shape/workspace mismatch (n_in %d, in0 %d, out %d, ws %zu); nothing launched\n", n_in, n_in > 0 ? in_sizes[0] : -1, out_size, ws_size); grid = -1; return; }
        int dev = 0, cus = 0, per_cu = 0;
        if (hipGetDevice(&dev) != hipSuccess || hipDeviceGetAttribute(&cus, hipDeviceAttributeMultiprocessorCount, dev) != hipSuccess) { fprintf(stderr, "kernel_launch: device query failed\n"); grid = -1; return; }
        if (hipFuncSetAttribute((const void*)hymba_fwd, hipFuncAttributeMaxDynamicSharedMemorySize, LDS_BYTES) != hipSuccess) { fprintf(stderr, "kernel_launch: hipFuncSetAttribute failed\n"); grid = -1; return; }
        if (hipOccupancyMaxActiveBlocksPerMultiprocessor(&per_cu, (const void*)hymba_fwd, NWAVES * 64, LDS_BYTES) != hipSuccess || per_cu < 1) { fprintf(stderr, "kernel_launch: occupancy query reports %d blocks per CU\n", per_cu); per_cu = 1; }
        (void)hipGetLastError();
        grid = cus;
    }
    if (grid < 0) return;
    if (hipMemsetAsync((char*)d_ws + WS_CTL, 0, 32768, stream) != hipSuccess) { fprintf(stderr, "kernel_launch: hipMemsetAsync of the barrier words failed; nothing launched\n"); return; }
    Args a{};
    for (int i = 0; i < 19; ++i) a.in[i] = (const float*)d_in[i];
    a.out = (float*)d_out; a.ws = (unsigned char*)d_ws;
    void* kargs[] = {&a};
    const hipError_t e = hipLaunchCooperativeKernel((const void*)hymba_fwd, dim3(grid), dim3(NWAVES * 64), kargs, LDS_BYTES, stream);
    if (e != hipSuccess) fprintf(stderr, "kernel_launch: cooperative launch failed: %s (grid %d)\n", hipGetErrorString(e), grid);
}
```
